# Optimizing an MI355X kernel written in HIP

```python
import jax, jax.numpy as jnp
from jax import lax
import numpy as np

D_MODEL = 2048
BATCH = 2
SEQ = 4096
DEPTH = 1

D_MIX = D_MODEL
ATTN_HEADS = 8
HEAD_DIM = 128
D_ATTN = ATTN_HEADS * HEAD_DIM
SGU_GROUPS = 8
SGU_GROUP_DIM = (D_MIX - D_ATTN) // SGU_GROUPS
D_SGU = SGU_GROUPS * SGU_GROUP_DIM
D_IN = 3 * D_ATTN + 2 * D_SGU
MOBA_BLOCK = 256
MOBA_TOPK = 3
Q_CHUNK = 32
SGU_CHUNK = 128
D_FF = 5632
EPS = 1e-6
NEG_INF = -1e30

kernel_name = 'hymba_moba_sgu_macaron'


def rmsnorm(x, g):
    xf = x.astype(jnp.float32)
    y = xf * lax.rsqrt(jnp.mean(xf * xf, axis=-1, keepdims=True) + EPS)
    return (y * g.astype(jnp.float32)).astype(x.dtype)


def swiglu(h, w_gate, w_up, w_down):
    return (jax.nn.silu(h @ w_gate) * (h @ w_up)) @ w_down


def pad_seq(a, axis, multiple):
    s = a.shape[axis]
    s_pad = -(-s // multiple) * multiple
    widths = [(0, 0)] * a.ndim
    widths[axis] = (0, s_pad - s)
    return jnp.pad(a, widths), s_pad


def moba_attention(q, k, v):
    B, H, S, Dh = q.shape
    q, S_pad = pad_seq(q, 2, MOBA_BLOCK)
    k, _ = pad_seq(k, 2, MOBA_BLOCK)
    v, _ = pad_seq(v, 2, MOBA_BLOCK)
    nb = S_pad // MOBA_BLOCK
    kb = k.reshape(B, H, nb, MOBA_BLOCK, Dh)
    vb = v.reshape(B, H, nb, MOBA_BLOCK, Dh)
    k_mean = jnp.mean(kb.astype(jnp.float32), axis=3)
    q_blk = jnp.arange(S_pad) // MOBA_BLOCK
    gate = jnp.einsum('bhsd,bhnd->bhsn', q.astype(jnp.float32), k_mean)
    fully_past = jnp.arange(nb)[None, :] < q_blk[:, None]
    gate = jnp.where(fully_past, gate, NEG_INF)
    topk = min(MOBA_TOPK, nb)
    _, sel_idx = lax.top_k(gate, topk)
    sel_valid = jnp.arange(topk)[None, :] < q_blk[:, None]
    gather = jax.vmap(jax.vmap(lambda blocks, ids: blocks[ids]))
    scale = HEAD_DIM ** -0.5

    def chunk(c):
        start = c * Q_CHUNK
        q_c = lax.dynamic_slice_in_dim(q, start, Q_CHUNK, axis=2)
        idx_c = lax.dynamic_slice_in_dim(sel_idx, start, Q_CHUNK, axis=2)
        valid_c = lax.dynamic_slice_in_dim(sel_valid, start, Q_CHUNK, axis=0)
        own = start // MOBA_BLOCK
        k_own = lax.dynamic_index_in_dim(kb, own, axis=2, keepdims=False)
        v_own = lax.dynamic_index_in_dim(vb, own, axis=2, keepdims=False)
        q_pos = start + jnp.arange(Q_CHUNK)
        k_pos = own * MOBA_BLOCK + jnp.arange(MOBA_BLOCK)
        s_own = jnp.einsum('bhqd,bhkd->bhqk', q_c, k_own).astype(jnp.float32) * scale
        s_own = jnp.where(k_pos[None, :] <= q_pos[:, None], s_own, NEG_INF)
        k_sel = gather(kb, idx_c)
        v_sel = gather(vb, idx_c)
        s_sel = jnp.einsum('bhqd,bhqjkd->bhqjk', q_c, k_sel).astype(jnp.float32) * scale
        s_sel = jnp.where(valid_c[:, :, None], s_sel, NEG_INF)
        s_all = jnp.concatenate(
            [s_own, s_sel.reshape(B, H, Q_CHUNK, topk * MOBA_BLOCK)], axis=-1)
        p = jax.nn.softmax(s_all, axis=-1).astype(v.dtype)
        p_own = p[..., :MOBA_BLOCK]
        p_sel = p[..., MOBA_BLOCK:].reshape(B, H, Q_CHUNK, topk, MOBA_BLOCK)
        return (jnp.einsum('bhqk,bhkd->bhqd', p_own, v_own)
                + jnp.einsum('bhqjk,bhqjkd->bhqd', p_sel, v_sel))

    out = lax.map(chunk, jnp.arange(S_pad // Q_CHUNK))
    out = out.transpose(1, 2, 0, 3, 4).reshape(B, H, S_pad, Dh)
    return out[:, :, :S]


def spatial_gating(z, ln_g, ln_b, w_s, b_s):
    B, S, _ = z.shape
    u, g = jnp.split(z, 2, axis=-1)
    g = g.reshape(B, S, SGU_GROUPS, SGU_GROUP_DIM)
    gf = g.astype(jnp.float32)
    mu = jnp.mean(gf, axis=-1, keepdims=True)
    var = jnp.mean(jnp.square(gf - mu), axis=-1, keepdims=True)
    gf = (gf - mu) * lax.rsqrt(var + EPS)
    g = (gf * ln_g.reshape(SGU_GROUPS, SGU_GROUP_DIM)
         + ln_b.reshape(SGU_GROUPS, SGU_GROUP_DIM)).astype(z.dtype)
    g, S_pad = pad_seq(g, 1, SGU_CHUNK)
    gc = g.reshape(B, S_pad // SGU_CHUNK, SGU_CHUNK, SGU_GROUPS, SGU_GROUP_DIM)
    w = jnp.tril(w_s)
    mixed = jnp.einsum('gts,bnsgc->bntgc', w, gc) + b_s.T[None, None, :, :, None]
    mixed = mixed.reshape(B, S_pad, D_SGU)[:, :S]
    return u * mixed


def setup_inputs(seed: int = 0) -> dict:
    key = jax.random.key(seed)
    ks = jax.random.split(key, 20)
    n = lambda k, shape, s: jax.random.normal(k, shape, jnp.float32) * s
    gain = lambda k, shape: 1.0 + 0.05 * jax.random.normal(k, shape, jnp.float32)
    L = DEPTH
    return {
        'x': n(ks[0], (BATCH, SEQ, D_MODEL), 1.0),
        'ffn1_norm': gain(ks[1], (L, D_MODEL)),
        'ffn1_w_gate': n(ks[2], (L, D_MODEL, D_FF), D_MODEL ** -0.5),
        'ffn1_w_up': n(ks[3], (L, D_MODEL, D_FF), D_MODEL ** -0.5),
        'ffn1_w_down': n(ks[4], (L, D_FF, D_MODEL), D_FF ** -0.5),
        'mix_norm': gain(ks[5], (L, D_MODEL)),
        'w_in': n(ks[6], (L, D_MODEL, D_IN), D_MODEL ** -0.5),
        'q_norm': gain(ks[7], (L, HEAD_DIM)),
        'k_norm': gain(ks[8], (L, HEAD_DIM)),
        'sgu_ln_gain': gain(ks[9], (L, D_SGU)),
        'sgu_ln_bias': n(ks[10], (L, D_SGU), 0.02),
        'sgu_w_spatial': n(ks[11], (L, SGU_GROUPS, SGU_CHUNK, SGU_CHUNK), 0.5 * SGU_CHUNK ** -0.5),
        'sgu_b_spatial': 1.0 + 0.1 * jax.random.normal(ks[12], (L, SGU_GROUPS, SGU_CHUNK), jnp.float32),
        'attn_out_gain': gain(ks[13], (L, D_ATTN)),
        'sgu_out_gain': gain(ks[14], (L, D_SGU)),
        'w_out': n(ks[15], (L, D_MIX, D_MODEL), D_MIX ** -0.5),
        'ffn2_norm': gain(ks[16], (L, D_MODEL)),
        'ffn2_w_gate': n(ks[17], (L, D_MODEL, D_FF), D_MODEL ** -0.5),
        'ffn2_w_up': n(ks[18], (L, D_MODEL, D_FF), D_MODEL ** -0.5),
        'ffn2_w_down': n(ks[19], (L, D_FF, D_MODEL), D_FF ** -0.5),
    }


def reference(x, ffn1_norm, ffn1_w_gate, ffn1_w_up, ffn1_w_down, mix_norm, w_in,
              q_norm, k_norm, sgu_ln_gain, sgu_ln_bias, sgu_w_spatial, sgu_b_spatial,
              attn_out_gain, sgu_out_gain, w_out, ffn2_norm, ffn2_w_gate, ffn2_w_up,
              ffn2_w_down):
    B, S, _ = x.shape
    for l in range(DEPTH):
        h = rmsnorm(x, ffn1_norm[l])
        x = x + 0.5 * swiglu(h, ffn1_w_gate[l], ffn1_w_up[l], ffn1_w_down[l])
        h = rmsnorm(x, mix_norm[l])
        proj = h @ w_in[l]
        q = proj[..., :D_ATTN]
        k = proj[..., D_ATTN:2 * D_ATTN]
        v = proj[..., 2 * D_ATTN:3 * D_ATTN]
        z = proj[..., 3 * D_ATTN:]
        to_heads = lambda t: t.reshape(B, S, ATTN_HEADS, HEAD_DIM).transpose(0, 2, 1, 3)
        q = rmsnorm(to_heads(q), q_norm[l])
        k = rmsnorm(to_heads(k), k_norm[l])
        v = to_heads(v)
        attn = moba_attention(q, k, v).transpose(0, 2, 1, 3).reshape(B, S, D_ATTN)
        sgu = spatial_gating(jax.nn.gelu(z), sgu_ln_gain[l], sgu_ln_bias[l],
                             sgu_w_spatial[l], sgu_b_spatial[l])
        mixed = jnp.concatenate(
            [rmsnorm(attn, attn_out_gain[l]), rmsnorm(sgu, sgu_out_gain[l])], axis=-1)
        x = x + mixed @ w_out[l]
        h = rmsnorm(x, ffn2_norm[l])
        x = x + 0.5 * swiglu(h, ffn2_w_gate[l], ffn2_w_up[l], ffn2_w_down[l])
    return x
```

```cpp
#include <hip/hip_runtime.h>
#include <cstdio>
#define MK_N_LAUNCHES 10
#include <cstdint>
namespace pg8 {
#define PG8_LAS __attribute__((address_space(3)))
typedef unsigned short bf16_t;
typedef short bf16x8 __attribute__((ext_vector_type(8)));
typedef float f32x4 __attribute__((ext_vector_type(4)));
typedef unsigned u32x4 __attribute__((ext_vector_type(4)));
constexpr int BM = 256, BK = 64, HALF = 128, HTB = HALF * BK * 2  , STAGE_BYTES = 8 * HTB, NXCD = 8, WGM = 8;

__host__ __device__ __forceinline__ int lds_byte(int r, int c) { const int st = (r >> 4) * 2 + (c >> 5), rr = r & 15, cc = c & 31, ob = rr * 64 + cc * 2; return st * 1024 + (ob ^ (((ob >> 9) & 1) << 5)); }
__host__ __device__ __forceinline__ void stage_rc(int b, int& R, int& C) { const int st = b / 1024, sb = b % 1024, swz = sb ^ (((sb >> 9) & 1) << 5); R = (st >> 1) * 16 + swz / 64; C = (st & 1) * 32 + (swz % 64) / 2; }
__host__ __device__ __forceinline__ int perm32(int rho) { const int n = rho >> 4, i = rho & 15; return 8 * (i >> 2) + 4 * n + (i & 3); }

struct Unit { int pm, pn; };
struct Gemm { const bf16_t* A; const bf16_t* Bt; int M, N, K; };

struct StaticOrder {
    int nM, nN, nwg, G, c;
    __host__ __device__ void init(int M, int N, int G_, int c_) { nM = M / BM; nN = N / BM; nwg = nM * nN; G = G_; c = c_; }
    __host__ __device__ bool next(int i, Unit& u) const {
        const long L = (long)i * G + c; if (L >= nwg) return false;
        int wgid = (int)L; { const int q = nwg / NXCD, r = nwg % NXCD, xcd = wgid % NXCD, off = wgid / NXCD; wgid = (xcd < r ? xcd * (q + 1) : r * (q + 1) + (xcd - r) * q) + off; }
        const int nig = WGM * nN, gid = wgid / nig, fm = gid * WGM, gsz = (nM - fm) < WGM ? (nM - fm) : WGM;
        u.pm = fm + ((wgid % nig) % gsz); u.pn = (wgid % nig) / gsz; return true;
    }
    __device__ __forceinline__ void a_ready(const Unit&) const {}
    __device__ __forceinline__ void done(const Unit&) const {}
};

__device__ __forceinline__ unsigned cvt_pk_bf16(float lo, float hi) { unsigned r; asm volatile("v_cvt_pk_bf16_f32 %0, %1, %2" : "=v"(r) : "v"(lo), "v"(hi)); return r; }
constexpr int DMODEL = 2048;
__device__ __forceinline__ float row_rs(const float* ss, int row) {
    const f32x4 a = *(const f32x4*)(ss + (size_t)row * 8), b = *(const f32x4*)(ss + (size_t)row * 8 + 4);
    const float s = ((a[0] + a[1]) + (a[2] + a[3])) + ((b[0] + b[1]) + (b[2] + b[3]));
    return 1.0f / sqrtf(s * (1.0f / DMODEL) + 1e-6f);
}
__device__ __forceinline__ float silu_f(float g) { return g * __builtin_amdgcn_rcpf(1.0f + __builtin_amdgcn_exp2f(-1.4426950408889634f * g)); }
__device__ __forceinline__ float gelu_f(float z) { const float t = z * (1.0f + 0.044715f * z * z); return z * __builtin_amdgcn_rcpf(1.0f + __builtin_amdgcn_exp2f(-2.302208198f * t)); }

struct EpiSwiGLU {
    static constexpr bool PERM = true, AFTER_DRAIN = false;
    bf16_t* O; int ldc; const float* ss;
    __device__ __forceinline__ void operator()(const f32x4 (&acc)[2][2][4][2], const Unit& u, int wr, int wc, int fr, int fq) const {
        const int row0 = u.pm * BM + wr * 64 + fr, col0 = u.pn * HALF + wc * 32 + 8 * fq;
#pragma unroll
        for (int ai = 0; ai < 2; ++ai)
#pragma unroll
            for (int m = 0; m < 4; ++m) { const int row = row0 + ai * HALF + m * 16; const float r = ss ? row_rs(ss, row) : 1.0f;
                float a[8];
#pragma unroll
                for (int n = 0; n < 2; ++n)
#pragma unroll
                    for (int j = 0; j < 4; ++j) a[n * 4 + j] = silu_f(acc[ai][0][m][n][j] * r) * (acc[ai][1][m][n][j] * r);
                u32x4 w; w.x = cvt_pk_bf16(a[0], a[1]); w.y = cvt_pk_bf16(a[2], a[3]); w.z = cvt_pk_bf16(a[4], a[5]); w.w = cvt_pk_bf16(a[6], a[7]);
                *(u32x4*)(O + (size_t)row * ldc + col0) = w; }
    }
};
struct EpiG3 {
    static constexpr bool PERM = true, AFTER_DRAIN = false;
    float* QK; bf16_t* V; bf16_t* UG; const float* ss;
    __device__ __forceinline__ void operator()(const f32x4 (&acc)[2][2][4][2], const Unit& u, int wr, int wc, int fr, int fq) const {
        const int row0 = u.pm * BM + wr * 64 + fr, cw = wc * 32 + 8 * fq, pn = u.pn;
#pragma unroll
        for (int ai = 0; ai < 2; ++ai)
#pragma unroll
            for (int m = 0; m < 4; ++m) { const int row = row0 + ai * HALF + m * 16; const float r = row_rs(ss, row);
#pragma unroll
                for (int bj = 0; bj < 2; ++bj) { f32x4 v0 = acc[ai][bj][m][0] * r, v1 = acc[ai][bj][m][1] * r;
                    if (pn < 8) { float* p = QK + (size_t)row * 2048 + pn * BM + bj * HALF + cw; *(f32x4*)p = v0; *(f32x4*)(p + 4) = v1; }
                    else { if (pn >= 12) {
#pragma unroll
                            for (int j = 0; j < 4; ++j) { v0[j] = gelu_f(v0[j]); v1[j] = gelu_f(v1[j]); } }
                        u32x4 w; w.x = cvt_pk_bf16(v0[0], v0[1]); w.y = cvt_pk_bf16(v0[2], v0[3]); w.z = cvt_pk_bf16(v1[0], v1[1]); w.w = cvt_pk_bf16(v1[2], v1[3]);
                        bf16_t* p = (pn < 12) ? V + (size_t)row * 1024 + (pn - 8) * BM + bj * HALF + cw : UG + (size_t)row * 2048 + (pn - 12) * BM + bj * HALF + cw;
                        *(u32x4*)p = w; } } }
    }
};
struct EpiResid {
    static constexpr bool PERM = false, AFTER_DRAIN = true;
    const float* base; float* out; bf16_t* xb; float* ss; float alpha;
    __device__ __forceinline__ void fused(f32x4 (&acc)[2][2][4][2], const Unit& u, int wr, int wc, int fr, int fq, PG8_LAS unsigned char* lds, int wid, int lane) const {
        typedef unsigned u32x2v __attribute__((ext_vector_type(2)));
        PG8_LAS float* P = (PG8_LAS float*)lds;
        const int col0 = u.pn * BM + wc * 32 + 4 * fq;
#pragma unroll
        for (int ai = 0; ai < 2; ++ai)
#pragma unroll
            for (int m = 0; m < 4; ++m) { const int rl = ai * HALF + wr * 64 + m * 16 + fr; const size_t off = (size_t)(u.pm * BM + rl) * DMODEL + col0; float q = 0.f;
#pragma unroll
                for (int bj = 0; bj < 2; ++bj)
#pragma unroll
                    for (int n = 0; n < 2; ++n) { const f32x4 bs = *(const f32x4*)(base + off + bj * HALF + n * 16); const f32x4 v = bs + acc[ai][bj][m][n] * alpha;
                        *(f32x4*)(out + off + bj * HALF + n * 16) = v;
                        if (xb) { u32x2v w; w.x = cvt_pk_bf16(v[0], v[1]); w.y = cvt_pk_bf16(v[2], v[3]); *(u32x2v*)(xb + off + bj * HALF + n * 16) = w; }
                        q += (v[0] * v[0] + v[1] * v[1]) + (v[2] * v[2] + v[3] * v[3]); }
                if (ss) { q += __shfl_xor(q, 16); q += __shfl_xor(q, 32); if (fq == 0) P[rl * 4 + wc] = q; }
                if (m & 1) asm volatile("" ::: "memory"); }
        if (ss) {
            asm volatile("s_waitcnt lgkmcnt(0)" ::: "memory"); __builtin_amdgcn_s_barrier(); asm volatile("" ::: "memory");
            const int t = wid * 64 + lane;
            if (t < 256) { const f32x4 p = *(const PG8_LAS f32x4*)(P + t * 4); ss[(size_t)(u.pm * BM + t) * 8 + u.pn] = (p[0] + p[1]) + (p[2] + p[3]); }
        }
    }
};

template <class Epi, class Sched, bool ALIGN_EPI = false, bool SP2 = false>
__device__ __forceinline__ void gemm_phase(PG8_LAS unsigned char* lds, const Gemm g, const Sched& S, const Epi& E) {
    const int tid = threadIdx.x, wid = __builtin_amdgcn_readfirstlane(tid >> 6), lane = tid & 63, wr = wid >> 2, wc = wid & 3, fr = lane & 15, fq = lane >> 4;
    const int K = g.K, nt = K / BK;
    unsigned voffA[2], voffB[2];
#pragma unroll
    for (int i = 0; i < 2; ++i) { int R, C; stage_rc(tid * 16 + i * 8192, R, C); const int Rb = Epi::PERM ? ((R & ~31) + perm32(R & 31)) : R;
        voffA[i] = (unsigned)(R * K + C) * 2u; voffB[i] = (unsigned)(Rb * K + C) * 2u; }
    const size_t kstep = (size_t)(BK * 2);
    const size_t hstep = (size_t)HALF * K * 2;
    const size_t tstep = 2 * hstep;
    const unsigned ldsw = (unsigned)wid * 1024u;
    const int aoff = lds_byte(wr * 64 + fr, fq * 8), boff = lds_byte(wc * 32 + fr, fq * 8);
#define PG8_SA(b, h) (((b) * 2 + (h)) * HTB)
#define PG8_SB(b, h) ((4 + (b) * 2 + (h)) * HTB)
#define PG8_STAGE(bufoff, gbase, voff) do { _Pragma("unroll") for (int _i = 0; _i < 2; ++_i) \
        __builtin_amdgcn_global_load_lds((const unsigned*)((const char*)(gbase) + (voff)[_i]), (PG8_LAS unsigned*)(lds + (bufoff) + ldsw + _i * 8192), 16, 0, 0); } while (0)
#define PG8_LDA(dst, b, h) do { _Pragma("unroll") for (int m = 0; m < 4; ++m) _Pragma("unroll") for (int k = 0; k < 2; ++k) dst[m][k] = *(const PG8_LAS bf16x8*)(lds + PG8_SA(b, h) + aoff + m * 2048 + k * 1024); } while (0)
#define PG8_LDB(dst, b, h) do { _Pragma("unroll") for (int n = 0; n < 2; ++n) _Pragma("unroll") for (int k = 0; k < 2; ++k) dst[n][k] = *(const PG8_LAS bf16x8*)(lds + PG8_SB(b, h) + boff + n * 2048 + k * 1024); } while (0)
#define PG8_MMA(ai, bj, At, Bt) do { __builtin_amdgcn_s_setprio(1); _Pragma("unroll") for (int m = 0; m < 4; ++m) _Pragma("unroll") for (int n = 0; n < 2; ++n) _Pragma("unroll") for (int k = 0; k < 2; ++k) \
        acc[ai][bj][m][n] = __builtin_amdgcn_mfma_f32_16x16x32_bf16(Bt[n][k], At[m][k], acc[ai][bj][m][n], 0, 0, 0); __builtin_amdgcn_s_setprio(0); } while (0)
#define PG8_WAIT_V(n) asm volatile("s_waitcnt vmcnt(" #n ")" ::: "memory")
#define PG8_WAIT_L(n) asm volatile("s_waitcnt lgkmcnt(" #n ")" ::: "memory")
#define PG8_BAR __builtin_amdgcn_s_barrier()
#define PG8_SCHED __builtin_amdgcn_sched_barrier(0)
    Unit cur, nxt; int ui = 0;
    if (!S.next(0, cur)) return;
    f32x4 acc[2][2][4][2];
#pragma unroll
    for (int a = 0; a < 2; ++a)
#pragma unroll
        for (int b = 0; b < 2; ++b)
#pragma unroll
            for (int m = 0; m < 4; ++m)
#pragma unroll
                for (int n = 0; n < 2; ++n) acc[a][b][m][n] = (f32x4){0.f, 0.f, 0.f, 0.f};
    bf16x8 At[4][2], B0[2][2], B1[2][2];
    const char* cA = (const char*)g.A + (size_t)cur.pm * tstep; const char* cB = (const char*)g.Bt + (size_t)cur.pn * tstep;
    S.a_ready(cur);
    if constexpr (SP2) {
        PG8_STAGE(PG8_SB(0, 0), cB, voffB); PG8_STAGE(PG8_SB(0, 1), cB + hstep, voffB); PG8_STAGE(PG8_SA(0, 0), cA, voffA); PG8_STAGE(PG8_SA(0, 1), cA + hstep, voffA);
        if (wr == 1) PG8_BAR;
        PG8_WAIT_V(2); PG8_BAR;
        PG8_STAGE(PG8_SB(1, 0), cB + kstep, voffB); PG8_STAGE(PG8_SA(1, 0), cA + kstep, voffA); PG8_STAGE(PG8_SB(1, 1), cB + hstep + kstep, voffB);
        PG8_WAIT_V(6); PG8_BAR;
    } else {
        PG8_STAGE(PG8_SB(0, 0), cB, voffB); PG8_STAGE(PG8_SA(0, 0), cA, voffA); PG8_STAGE(PG8_SB(0, 1), cB + hstep, voffB); PG8_STAGE(PG8_SA(0, 1), cA + hstep, voffA);
        if (wr == 1) PG8_BAR;
        PG8_WAIT_V(4); PG8_BAR;
        PG8_STAGE(PG8_SB(1, 0), cB + kstep, voffB); PG8_STAGE(PG8_SA(1, 0), cA + kstep, voffA); PG8_STAGE(PG8_SB(1, 1), cB + hstep + kstep, voffB);
        PG8_WAIT_V(6); PG8_BAR;
    }
    for (;;) {
        const bool has_next = S.next(ui + 1, nxt);
        const char* nA = has_next ? (const char*)g.A + (size_t)nxt.pm * tstep : cA; const char* nB = has_next ? (const char*)g.Bt + (size_t)nxt.pn * tstep : cB;
        for (int t = 0; t < nt; t += 2) {
            const bool last = (t == nt - 2);
            const char* a1 = cA + (size_t)(t + 1) * kstep;
            const char* a2 = last ? nA : cA + (size_t)(t + 2) * kstep; const char* b2 = last ? nB : cB + (size_t)(t + 2) * kstep;
            const char* a3 = a2 + kstep; const char* b3 = b2 + kstep;
            if (last && has_next) S.a_ready(nxt);
            if constexpr (SP2) {
            PG8_LDB(B0, 0, 0); PG8_LDB(B1, 0, 1); PG8_SCHED; PG8_LDA(At, 0, 0); PG8_STAGE(PG8_SA(1, 1), a1 + hstep, voffA);
            PG8_WAIT_V(8); PG8_WAIT_L(0); PG8_BAR; PG8_MMA(0, 0, At, B0); PG8_MMA(0, 1, At, B1); PG8_BAR; PG8_SCHED;
            PG8_LDA(At, 0, 1); PG8_STAGE(PG8_SB(0, 0), b2, voffB); PG8_STAGE(PG8_SB(0, 1), b2 + hstep, voffB); PG8_STAGE(PG8_SA(0, 0), a2, voffA);
            PG8_WAIT_V(8); PG8_WAIT_L(0); PG8_BAR; PG8_MMA(1, 0, At, B0); PG8_MMA(1, 1, At, B1); PG8_BAR; PG8_SCHED;
            PG8_LDB(B0, 1, 0); PG8_LDB(B1, 1, 1); PG8_SCHED; PG8_LDA(At, 1, 0); PG8_STAGE(PG8_SA(0, 1), a2 + hstep, voffA);
            PG8_WAIT_V(8); PG8_WAIT_L(0); PG8_BAR; PG8_MMA(0, 0, At, B0); PG8_MMA(0, 1, At, B1); PG8_BAR; PG8_SCHED;
            PG8_LDA(At, 1, 1); PG8_STAGE(PG8_SB(1, 0), b3, voffB); PG8_STAGE(PG8_SB(1, 1), b3 + hstep, voffB); PG8_STAGE(PG8_SA(1, 0), a3, voffA);
            PG8_WAIT_V(8); PG8_WAIT_L(0); PG8_BAR; PG8_MMA(1, 0, At, B0); PG8_MMA(1, 1, At, B1); PG8_BAR; PG8_SCHED;
            } else {
            PG8_LDB(B0, 0, 0); PG8_SCHED; PG8_LDA(At, 0, 0); PG8_STAGE(PG8_SA(1, 1), a1 + hstep, voffA);
            PG8_WAIT_L(8); PG8_BAR; PG8_WAIT_L(0); PG8_MMA(0, 0, At, B0); PG8_BAR; PG8_SCHED;
            PG8_LDB(B1, 0, 1); PG8_STAGE(PG8_SB(0, 0), b2, voffB);
            PG8_BAR; PG8_WAIT_L(0); PG8_MMA(0, 1, At, B1); PG8_BAR;
            PG8_LDA(At, 0, 1); PG8_STAGE(PG8_SA(0, 0), a2, voffA);
            PG8_BAR; PG8_WAIT_L(0); PG8_MMA(1, 0, At, B0); PG8_BAR; PG8_SCHED;
            PG8_STAGE(PG8_SB(0, 1), b2 + hstep, voffB);
            PG8_WAIT_V(6); PG8_BAR; PG8_MMA(1, 1, At, B1); PG8_BAR;
            PG8_LDB(B0, 1, 0); PG8_SCHED; PG8_LDA(At, 1, 0); PG8_STAGE(PG8_SA(0, 1), a2 + hstep, voffA);
            PG8_WAIT_L(8); PG8_BAR; PG8_WAIT_L(0); PG8_MMA(0, 0, At, B0); PG8_BAR; PG8_SCHED;
            PG8_LDB(B1, 1, 1); PG8_STAGE(PG8_SB(1, 0), b3, voffB);
            PG8_BAR; PG8_WAIT_L(0); PG8_MMA(0, 1, At, B1); PG8_BAR;
            PG8_LDA(At, 1, 1); PG8_STAGE(PG8_SA(1, 0), a3, voffA);
            PG8_BAR; PG8_WAIT_L(0); PG8_MMA(1, 0, At, B0); PG8_BAR; PG8_SCHED;
            PG8_STAGE(PG8_SB(1, 1), b3 + hstep, voffB);
            PG8_WAIT_V(6); PG8_BAR; PG8_MMA(1, 1, At, B1); PG8_BAR;
            }
        }
        if constexpr (ALIGN_EPI) { if (wr == 0) PG8_BAR; }
        if constexpr (!Epi::AFTER_DRAIN) { E(acc, cur, wr, wc, fr, fq); S.done(cur); }
        if (!has_next) break;
#pragma unroll
        for (int a = 0; a < 2; ++a)
#pragma unroll
            for (int b = 0; b < 2; ++b)
#pragma unroll
                for (int m = 0; m < 4; ++m)
#pragma unroll
                    for (int n = 0; n < 2; ++n) acc[a][b][m][n] = (f32x4){0.f, 0.f, 0.f, 0.f};
        cur = nxt; cA = nA; cB = nB; ++ui;
        if constexpr (ALIGN_EPI) { if (wr == 1) PG8_BAR; }
    }
    PG8_WAIT_V(0);
    if constexpr (!ALIGN_EPI) { if (wr == 0) PG8_BAR; }
    PG8_BAR;
    if constexpr (Epi::AFTER_DRAIN) { E.fused(acc, cur, wr, wc, fr, fq, lds, wid, lane); S.done(cur); }
#undef PG8_SA
#undef PG8_SB
#undef PG8_STAGE
#undef PG8_LDA
#undef PG8_LDB
#undef PG8_MMA
#undef PG8_WAIT_V
#undef PG8_WAIT_L
#undef PG8_BAR
#undef PG8_SCHED
}
}

namespace att {
#define ALDS __attribute__((address_space(3)))
typedef short bf16x8 __attribute__((ext_vector_type(8)));
typedef short s16x4 __attribute__((ext_vector_type(4)));
typedef float f32x16 __attribute__((ext_vector_type(16)));
typedef float f32x4 __attribute__((ext_vector_type(4)));
typedef unsigned u32x4 __attribute__((ext_vector_type(4)));
constexpr int NW = 8, QBLK = 32, KVBLK = 64, D = 128, SEQ = 4096, NHEAD = 8;
constexpr int SHM_V = KVBLK * D * 2, SHM_K = KVBLK * D * 2;
constexpr int OFF_V = 0, OFF_K = 2 * SHM_V, OFF_WS = 2 * SHM_V + 2 * SHM_K, ATT_LDS = OFF_WS + NW * 64 * 4;
constexpr size_t QK_PITCH = 8192;
#define KSWZ(row, colB) ((row) * 256 + ((colB) ^ (((row) & 7) << 4)))
#define SBAR() __builtin_amdgcn_sched_barrier(0)
__device__ __forceinline__ int v_st(int k, int c) { const int kk = (k & ~0xC) | ((k & 4) << 1) | ((k & 8) >> 1); return ((kk >> 3) * 4 + (c >> 5)) * 512 + ((kk & 7) * 32 + (c & 31)) * 2; }
__device__ __forceinline__ int v_rd_base(int lane) { return ((lane & 3) << 3) | (((lane >> 2) & 3) << 6) | (((lane >> 4) & 1) << 5) | (((lane >> 5) & 1) << 8); }
constexpr int v_rd_off(int d0, int ks, int half) { return d0 * 512 + ks * 4096 + half * 2048; }
__device__ __forceinline__ int crow(int r, int hi) { return (r & 3) + 8 * (r >> 2) + 4 * hi; }
__device__ __forceinline__ unsigned cvtpk(float lo, float hi) { unsigned r; asm volatile("v_cvt_pk_bf16_f32 %0, %1, %2" : "=v"(r) : "v"(lo), "v"(hi)); return r; }
constexpr float THR2 = 11.5f;

__device__ __forceinline__ void partialSM(f32x16& p0, f32x16& p1, float& m_reg, float& mn, float& alpha) {
    float pmax = p0[0];
#pragma unroll
    for (int r = 1; r < 16; ++r) pmax = fmaxf(pmax, p0[r]);
#pragma unroll
    for (int r = 0; r < 16; ++r) pmax = fmaxf(pmax, p1[r]);
    { auto rr = __builtin_amdgcn_permlane32_swap(__float_as_uint(pmax), __float_as_uint(pmax), false, false);
      pmax = fmaxf(__uint_as_float(rr[0]), __uint_as_float(rr[1])); }
    if (__builtin_expect(__all((pmax - m_reg) <= THR2), 1)) { mn = m_reg; alpha = 1.f; }
    else { mn = fmaxf(m_reg, pmax); alpha = __builtin_amdgcn_exp2f(m_reg - mn); m_reg = mn; }
#pragma unroll
    for (int r = 0; r < 16; ++r) p0[r] = __builtin_amdgcn_exp2f(p0[r] - mn);
#pragma unroll
    for (int r = 0; r < 16; ++r) p1[r] = __builtin_amdgcn_exp2f(p1[r] - mn);
}
__device__ __forceinline__ void finishSM(f32x16& p0, f32x16& p1, float alpha, float& l_reg, bf16x8& pa0, bf16x8& pa1, bf16x8& pa2, bf16x8& pa3) {
    float ps = 0;
#pragma unroll
    for (int r = 0; r < 16; ++r) ps += p0[r];
#pragma unroll
    for (int r = 0; r < 16; ++r) ps += p1[r];
    { auto rr = __builtin_amdgcn_permlane32_swap(__float_as_uint(ps), __float_as_uint(ps), false, false);
      ps = __uint_as_float(rr[0]) + __uint_as_float(rr[1]); }
    l_reg = l_reg * alpha + ps;
#define PK4(P, B_, OUT) do { unsigned a0 = cvtpk(P[B_+0], P[B_+1]), a1 = cvtpk(P[B_+2], P[B_+3]);                          \
        unsigned b0 = cvtpk(P[B_+4], P[B_+5]), b1 = cvtpk(P[B_+6], P[B_+7]);                                             \
        auto r0 = __builtin_amdgcn_permlane32_swap(a0, b0, false, false); auto r1 = __builtin_amdgcn_permlane32_swap(a1, b1, false, false); \
        u32x4 w = {r0[0], r1[0], r0[1], r1[1]}; OUT = __builtin_bit_cast(bf16x8, w); } while (0)
    PK4(p0, 0, pa0); PK4(p0, 8, pa1); PK4(p1, 0, pa2); PK4(p1, 8, pa3);
#undef PK4
}
__device__ __forceinline__ void qkt(f32x16& p0, f32x16& p1, const ALDS char* Kt, int r32, int hi, const bf16x8* qr) {
    p0 = f32x16{}; p1 = f32x16{};
    const ALDS char* kb[4];
#pragma unroll
    for (int dd = 0; dd < 4; ++dd) kb[dd] = Kt + KSWZ(r32, (dd * 16 + hi * 8) * 2);
#pragma unroll
    for (int d0 = 0; d0 < 8; ++d0) { const ALDS char* a = kb[d0 & 3] + (d0 >> 2) * 128;
        bf16x8 b0 = *reinterpret_cast<const ALDS bf16x8*>(a);
        bf16x8 b1 = *reinterpret_cast<const ALDS bf16x8*>(a + 32 * 256);
        p0 = __builtin_amdgcn_mfma_f32_32x32x16_bf16(b0, qr[d0], p0, 0, 0, 0);
        p1 = __builtin_amdgcn_mfma_f32_32x32x16_bf16(b1, qr[d0], p1, 0, 0, 0); }
}
__device__ __forceinline__ void pv_tile(f32x16* o, int vb, bf16x8 pa0, bf16x8 pa1, bf16x8 pa2, bf16x8 pa3) {
#define TRRD(dst, off) asm volatile("ds_read_b64_tr_b16 %0, %1 offset:%2" : "=&v"(dst) : "v"(vb), "i"(off) : "memory")
#define PV_D0(d0) do { s16x4 l0, l1, l2, l3, h0, h1, h2, h3; constexpr int b_ = v_rd_off(d0, 0, 0); \
        TRRD(l0, b_); TRRD(h0, b_ + 2048); TRRD(l1, b_ + 4096); TRRD(h1, b_ + 6144); TRRD(l2, b_ + 8192); TRRD(h2, b_ + 10240); TRRD(l3, b_ + 12288); TRRD(h3, b_ + 14336); \
        asm volatile("s_waitcnt lgkmcnt(0)" ::: "memory"); SBAR();   \
        o[d0] = __builtin_amdgcn_mfma_f32_32x32x16_bf16(pa0, (bf16x8){l0[0], l0[1], l0[2], l0[3], h0[0], h0[1], h0[2], h0[3]}, o[d0], 0, 0, 0);   \
        o[d0] = __builtin_amdgcn_mfma_f32_32x32x16_bf16(pa1, (bf16x8){l1[0], l1[1], l1[2], l1[3], h1[0], h1[1], h1[2], h1[3]}, o[d0], 0, 0, 0);   \
        o[d0] = __builtin_amdgcn_mfma_f32_32x32x16_bf16(pa2, (bf16x8){l2[0], l2[1], l2[2], l2[3], h2[0], h2[1], h2[2], h2[3]}, o[d0], 0, 0, 0);   \
        o[d0] = __builtin_amdgcn_mfma_f32_32x32x16_bf16(pa3, (bf16x8){l3[0], l3[1], l3[2], l3[3], h3[0], h3[1], h3[2], h3[3]}, o[d0], 0, 0, 0); } while (0)
    PV_D0(0); PV_D0(1); PV_D0(2); PV_D0(3);
#undef PV_D0
#undef TRRD
}

__device__ __forceinline__ void attn_unit(int b, int h, int qb, const unsigned char* QKb, const unsigned short* Vb, const float* kmean, unsigned short* O, ALDS unsigned char* lds) {
    const int tid = threadIdx.x, wid = __builtin_amdgcn_readfirstlane(tid >> 6), lane = tid & 63, r32 = lane & 31, hi = lane >> 5;
    const size_t rowbase = (size_t)b * SEQ;
    const int qw = qb * 256 + wid * QBLK;
    ALDS char* V_lds = (ALDS char*)lds + OFF_V; ALDS char* K_lds = (ALDS char*)lds + OFF_K;
    ALDS float* ws = (ALDS float*)(lds + OFF_WS) + wid * 64; ALDS float* li_l = ws; ALDS float* al_l = ws + 32;
    bf16x8 qr[8];
    { const unsigned char* qp = QKb + (rowbase + qw + r32) * QK_PITCH + h * 512 + hi * 16;
#pragma unroll
      for (int d0 = 0; d0 < 8; ++d0) qr[d0] = *(const bf16x8*)(qp + d0 * 32); }
    unsigned selmask = 0u;
    if (qb > 0) {
        f32x16 g = f32x16{};
        const float* km = kmean + ((size_t)(b * NHEAD + h) * 16 + (r32 & 15)) * 128 + hi * 8;
#pragma unroll
        for (int d0 = 0; d0 < 8; ++d0) {
            f32x4 a = *(const f32x4*)(km + d0 * 16), c = *(const f32x4*)(km + d0 * 16 + 4);
            if (r32 >= 16) { a = (f32x4){0.f, 0.f, 0.f, 0.f}; c = a; }
            u32x4 wh = {cvtpk(a[0], a[1]), cvtpk(a[2], a[3]), cvtpk(c[0], c[1]), cvtpk(c[2], c[3])};
            f32x4 ra, rc;
#pragma unroll
            for (int j = 0; j < 2; ++j) { ra[2 * j] = a[2 * j] - __uint_as_float(wh[j] << 16); ra[2 * j + 1] = a[2 * j + 1] - __uint_as_float(wh[j] & 0xffff0000u);
                                          rc[2 * j] = c[2 * j] - __uint_as_float(wh[2 + j] << 16); rc[2 * j + 1] = c[2 * j + 1] - __uint_as_float(wh[2 + j] & 0xffff0000u); }
            u32x4 wl = {cvtpk(ra[0], ra[1]), cvtpk(ra[2], ra[3]), cvtpk(rc[0], rc[1]), cvtpk(rc[2], rc[3])};
            g = __builtin_amdgcn_mfma_f32_32x32x16_bf16(__builtin_bit_cast(bf16x8, wh), qr[d0], g, 0, 0, 0);
            g = __builtin_amdgcn_mfma_f32_32x32x16_bf16(__builtin_bit_cast(bf16x8, wl), qr[d0], g, 0, 0, 0);
        }
        float v[8];
#pragma unroll
        for (int r = 0; r < 8; ++r) { const int n = crow(r, hi); v[r] = (n < qb) ? g[r] : -3.0e38f; }
        const int rounds = qb < 3 ? qb : 3;
        for (int rd = 0; rd < rounds; ++rd) {
            float bv = v[0]; int bi = crow(0, hi);
#pragma unroll
            for (int r = 1; r < 8; ++r) { if (v[r] > bv) { bv = v[r]; bi = crow(r, hi); } }
            const float ov = __shfl_xor(bv, 32); const int oi = __shfl_xor(bi, 32);
            const bool mine = (bv > ov) || (bv == ov && bi < oi);
            const int wi = mine ? bi : oi;
            selmask |= 1u << wi;
#pragma unroll
            for (int r = 0; r < 8; ++r) if (crow(r, hi) == wi) v[r] = -3.0e38f;
        }
    }
    const int NT = 4 * (qb + 1);
    const int sr = tid >> 4, sc = (tid & 15) * 8, vst0 = v_st(sr, sc), vst1 = v_st(32 + sr, sc), kws = KSWZ(sr, sc * 2);
    const int vb0 = (int)(uintptr_t)V_lds + v_rd_base(lane);
    const unsigned char* Kg = QKb + 4096 + h * 512 + sc * 2 + (rowbase + sr) * QK_PITCH;
    const unsigned short* Vg = Vb + (rowbase + sr) * 1024 + h * 128 + sc;
    float m_reg = -1e30f, l_reg = 0.f; f32x16 o[4] = {};
    bf16x8 st_k0, st_k1, st_v0, st_v1;
#define KEY0(s) ((s) < 4 ? qb * 256 + 64 * (s) : ((s) - 4) * 64)
#define SLOAD(s) do { const size_t k0_ = (size_t)KEY0(s); st_k0 = *(const bf16x8*)(Kg + k0_ * QK_PITCH); st_k1 = *(const bf16x8*)(Kg + (k0_ + 32) * QK_PITCH); \
                      st_v0 = *(const bf16x8*)(Vg + k0_ * 1024); st_v1 = *(const bf16x8*)(Vg + (k0_ + 32) * 1024); } while (0)
#define SWRITE(bf) do { *(ALDS bf16x8*)(K_lds + (bf) * SHM_K + kws) = st_k0; *(ALDS bf16x8*)(K_lds + (bf) * SHM_K + kws + 32 * 256) = st_k1; \
                        *(ALDS bf16x8*)(V_lds + (bf) * SHM_V + vst0) = st_v0; *(ALDS bf16x8*)(V_lds + (bf) * SHM_V + vst1) = st_v1; } while (0)
    SLOAD(0); SWRITE(0); __syncthreads();
    const float NEG = -__builtin_inff();
    for (int s = 0; s < NT; ++s) {
        const int bf = s & 1;
        if (s + 1 < NT) SLOAD(s + 1);
        f32x16 p0, p1;
        qkt(p0, p1, K_lds + bf * SHM_K, r32, hi, qr);
        if (s < 4) {
            if (64 * s + 63 > wid * QBLK) { const int dq = wid * QBLK + r32 - 64 * s - 4 * hi;
#pragma unroll
                for (int r = 0; r < 16; ++r) { const int c = (r & 3) + 8 * (r >> 2); if (c > dq) p0[r] = NEG; if (c + 32 > dq) p1[r] = NEG; } }
        } else { const bool keep = (selmask >> ((s - 4) >> 2)) & 1u;
#pragma unroll
            for (int r = 0; r < 16; ++r) { p0[r] = keep ? p0[r] : NEG; p1[r] = keep ? p1[r] : NEG; } }
        float mn, alpha; bf16x8 pa0, pa1, pa2, pa3;
        partialSM(p0, p1, m_reg, mn, alpha);
        finishSM(p0, p1, alpha, l_reg, pa0, pa1, pa2, pa3);
        if (__any(alpha < 1.f)) { if (hi == 0) al_l[r32] = alpha; asm volatile("s_waitcnt lgkmcnt(0)" ::: "memory");
#pragma unroll
            for (int d_ = 0; d_ < 4; ++d_)
#pragma unroll
                for (int r = 0; r < 16; ++r) o[d_][r] *= al_l[crow(r, hi)]; }
        pv_tile(o, vb0 + bf * SHM_V, pa0, pa1, pa2, pa3);
        if (s + 1 < NT) SWRITE(bf ^ 1);
        __syncthreads();
    }
#undef SLOAD
#undef SWRITE
#undef KEY0
    if (hi == 0) li_l[r32] = l_reg;
    asm volatile("s_waitcnt lgkmcnt(0)" ::: "memory");
    ALDS unsigned short* stg = (ALDS unsigned short*)(lds + wid * 8192);
#pragma unroll
    for (int r = 0; r < 16; ++r) { const int orow = crow(r, hi); const float inv = 1.0f / li_l[orow];
#pragma unroll
        for (int d0 = 0; d0 < 4; ++d0) { const unsigned w = cvtpk(o[d0][r] * inv, 0.f); stg[orow * 128 + d0 * 32 + r32] = (unsigned short)(w & 0xffffu); } }
    asm volatile("s_waitcnt lgkmcnt(0)" ::: "memory");
    unsigned short* Ow = O + (rowbase + qw) * 2048 + h * 128;
#pragma unroll
    for (int i = 0; i < 8; ++i) { const int row = i * 4 + (lane >> 4), ch = lane & 15; const u32x4 v = *(const ALDS u32x4*)(stg + row * 128 + ch * 8); *(u32x4*)(Ow + (size_t)row * 2048 + ch * 8) = v; }
    __syncthreads();
}
#undef KSWZ
#undef SBAR
#undef ALDS
}

#define GAS __attribute__((address_space(1)))
#define LAS __attribute__((address_space(3)))
typedef unsigned short bf16;
typedef unsigned v4u __attribute__((ext_vector_type(4)));
typedef float f32x4 __attribute__((ext_vector_type(4)));
typedef short bf16x8 __attribute__((ext_vector_type(8)));
typedef GAS unsigned gu32;
typedef GAS unsigned long long gu64;
#define RLX_AGENT __ATOMIC_RELAXED, __HIP_MEMORY_SCOPE_AGENT
#define LDS_WAIT() asm volatile("s_waitcnt lgkmcnt(0)" ::: "memory")
#define VM_WAIT() asm volatile("s_waitcnt vmcnt(0)" ::: "memory")
__device__ __forceinline__ unsigned long long rt() { return __builtin_amdgcn_s_memrealtime(); }
__device__ __forceinline__ unsigned f2bf(float f) { unsigned u = __builtin_bit_cast(unsigned, f); return (u + 0x7fffu + ((u >> 16) & 1u)) >> 16; }
__device__ __forceinline__ unsigned pk2(float lo, float hi) { return f2bf(lo) | (f2bf(hi) << 16); }

#define XB_TMO      128
#define XB_XCNT(j)  (256  + 64 * (j))
#define XB_XSUB(j)  (1280 + 64 * (j))
#define XB_XGEN(j)  (2304 + 64 * (j))
#define XB_TOP      3328
#define XB_TOPGEN   3392
#define XCD_BAR_WORDS 3456
#define XB_SPIN_CAP (1u << 18)

__device__ __forceinline__ unsigned xb_ld(unsigned* p)              { return __hip_atomic_load(p, __ATOMIC_RELAXED, __HIP_MEMORY_SCOPE_AGENT); }
__device__ __forceinline__ unsigned xb_add(unsigned* p, unsigned v) { return __hip_atomic_fetch_add(p, v, __ATOMIC_RELAXED, __HIP_MEMORY_SCOPE_AGENT); }
__device__ __forceinline__ unsigned xb_xcc_id() { return (unsigned)__builtin_amdgcn_s_getreg((3 << 11) | 20) & 0xFu; }
#define XB_SPIN(cond, bar) do { unsigned _sp = 0; while (cond) { __builtin_amdgcn_s_sleep(1); \
    if ((++_sp & 255u) == 0u) { if (xb_ld(&(bar)[XB_TMO])) break; if (_sp > XB_SPIN_CAP) { atomicAdd(&(bar)[XB_TMO], 1u); break; } } } } while (0)

struct XcdBarrier {
    unsigned* bar; unsigned x;
    volatile LAS unsigned* st;
};

__device__ __forceinline__ XcdBarrier xcd_barrier_post(unsigned* bar, volatile LAS unsigned* st) {
    XcdBarrier b; b.bar = bar; b.x = xb_xcc_id(); b.st = st;
    if (threadIdx.x == 0) (void)xb_add(&bar[XB_XCNT(b.x)], 1u);
    return b;
}
__device__ __forceinline__ void xcd_barrier_complete(unsigned* bar, unsigned x, unsigned& nloc, unsigned& nx) {
    const unsigned G = gridDim.x * gridDim.y * gridDim.z;
    unsigned sum, cnt, mine, sp = 0u;
    for (;;) {
        sum = 0u; cnt = 0u; mine = 0u;
#pragma unroll
        for (unsigned j = 0; j < 16; ++j) { const unsigned c = xb_ld(&bar[XB_XCNT(j)]); sum += c; cnt += (c > 0u) ? 1u : 0u; mine = (j == x) ? c : mine; }
        if (sum == G) break;
        __builtin_amdgcn_s_sleep(1);
        if ((++sp & 255u) == 0u) { if (xb_ld(&bar[XB_TMO])) break; if (sp > XB_SPIN_CAP) { atomicAdd(&bar[XB_TMO], 1u); break; } }
    }
    nloc = mine > 0u ? mine : 1u; nx = cnt > 0u ? cnt : 1u;
}

__device__ __forceinline__ void xcd_barrier(const XcdBarrier& b) {
    asm volatile("s_waitcnt vmcnt(0)" ::: "memory");
    __syncthreads();
    if (threadIdx.x == 0) {
        unsigned* bar = b.bar;
        __builtin_amdgcn_s_waitcnt(0);
        unsigned nloc = b.st[0], nx = b.st[1];
        if (nloc == 0u) { xcd_barrier_complete(bar, b.x, nloc, nx); b.st[0] = nloc; b.st[1] = nx; }
        const unsigned old = xb_add(&bar[XB_XSUB(b.x)], 1u);
        const unsigned gen = old / nloc;
        if (old + 1u == (gen + 1u) * nloc) {
            __builtin_amdgcn_fence(__ATOMIC_RELEASE, "agent");
            asm volatile("s_waitcnt vmcnt(0)" ::: "memory");
            const unsigned og = xb_add(&bar[XB_TOP], 1u);
            const unsigned tg = og / nx;
            if (og + 1u == (tg + 1u) * nx) xb_add(&bar[XB_TOPGEN], 1u);
            else XB_SPIN(xb_ld(&bar[XB_TOPGEN]) == tg, bar);
            __builtin_amdgcn_fence(__ATOMIC_ACQUIRE, "agent");
            xb_add(&bar[XB_XGEN(b.x)], 1u);
            asm volatile("s_waitcnt vmcnt(0)" ::: "memory");
        } else {
            XB_SPIN(xb_ld(&bar[XB_XGEN(b.x)]) == gen, bar);
            __builtin_amdgcn_fence(__ATOMIC_ACQUIRE, "agent");
            asm volatile("s_waitcnt vmcnt(0)" ::: "memory");
        }
    }
    __syncthreads();
}
constexpr int NWAVES = 8;
#ifndef MK_N_LAUNCHES
#define MK_N_LAUNCHES 1
#endif
constexpr int N_PHASES = 10;
constexpr int N_LAUNCHES = MK_N_LAUNCHES;
static_assert(N_LAUNCHES == 1 || N_LAUNCHES == N_PHASES, "MK_N_LAUNCHES is 1 or N_PHASES");
constexpr int BATCH = 2, SEQ = 4096, DM = 2048, DFF = 5632, NHEAD = 8, HD = 128, DATT = 1024, DSGU = 1024, DIN = 5120, NGRP = 8, CHUNK = 128;
constexpr int M = BATCH * SEQ;
constexpr int N1 = 2 * DFF;
constexpr float EPS = 1e-6f;
constexpr float QSCALE = 0.08838834764831845f * 1.4426950408889634f;
constexpr size_t MiB = 1u << 20;
constexpr size_t WS_CTL = 0, CTL_ZERO_BYTES = 64 * 1024;
constexpr size_t WS_SS1 = 1 * MiB, WS_SS2 = 1 * MiB + 256 * 1024, WS_KMEAN = 1 * MiB + 512 * 1024;
constexpr size_t WS_W1 = 2 * MiB, WS_W2 = 46 * MiB, WS_WIN = 68 * MiB, WS_WOUT = 88 * MiB, WS_W5 = 96 * MiB, WS_W6 = 140 * MiB;
constexpr size_t WS_XA = 162 * MiB, WS_XB = 194 * MiB;
constexpr size_t WS_ACT = 226 * MiB;
constexpr size_t WS_QK = 226 * MiB, WS_V = 290 * MiB, WS_UG = 306 * MiB, WS_MIX = 338 * MiB, WS_END = 370 * MiB;
constexpr int CW_BAR = 4096;
constexpr int RING_BYTES = 131072, LDSCTL_OFF = RING_BYTES, MISC_OFF = LDSCTL_OFF + 320, LDS_BYTES = 147456;

struct Frame {
    LAS unsigned char* lds; volatile LAS unsigned* MISC; gu32* ctl;
    int tid, lane, wave, vcu, G;
};

__device__ __forceinline__ float wave_sum(float v) {
#pragma unroll
    for (int o = 1; o < 64; o <<= 1) v += __shfl_xor(v, o);
    return v;
}
__device__ __forceinline__ void p0_transpose_item(const float* W, int N, bf16* WT, int K, int k0, int n0, int drow0, const float* kg, LAS float* scr, int lane) {
#pragma unroll 8
    for (int i = 0; i < 32; ++i) { const int kk = 2 * i + (lane >> 5); float w = W[(size_t)(k0 + kk) * N + n0 + (lane & 31)]; if (kg) w *= kg[k0 + kk]; scr[kk * 33 + (lane & 31)] = w; }
    LDS_WAIT(); asm volatile("" ::: "memory");
    const int c = lane & 7;
#pragma unroll
    for (int j = 0; j < 4; ++j) { const int n = (lane >> 3) + 8 * j; const LAS float* s = scr + (8 * c) * 33 + n;
        v4u o; o.x = pk2(s[0 * 33], s[1 * 33]); o.y = pk2(s[2 * 33], s[3 * 33]); o.z = pk2(s[4 * 33], s[5 * 33]); o.w = pk2(s[6 * 33], s[7 * 33]);
        *(v4u*)(WT + (size_t)(drow0 + n) * K + k0 + 8 * c) = o; }
    LDS_WAIT(); asm volatile("" ::: "memory");
}
struct P0Mat { const float* W; int K, N; bf16* WT; const float* kg; int mode; };
__device__ __forceinline__ int p0_items(const P0Mat& m) { return (m.K / 64) * (m.N / 32); }
__device__ __forceinline__ void p0_do(const P0Mat& m, int item, LAS float* scr, int lane) {
    const int nblk = m.N / 32, kb = item / nblk, nb = item % nblk, n0 = 32 * nb;
    const int drow0 = m.mode == 0 ? n0 : 256 * (n0 >> 7) + (n0 & 127) + (m.mode == 2 ? 128 : 0);
    p0_transpose_item(m.W, m.N, m.WT, m.K, 64 * kb, n0, drow0, m.kg, scr, lane);
}
__device__ __forceinline__ void rms_row_to_bf16(const float* xrow, const float* g, bf16* orow, int lane) {
    const f32x4* xr = (const f32x4*)xrow + lane; const f32x4* gr = (const f32x4*)g + lane;
    f32x4 v[8]; float s = 0.f;
#pragma unroll
    for (int j = 0; j < 8; ++j) { v[j] = xr[64 * j]; s += (v[j].x * v[j].x + v[j].y * v[j].y) + (v[j].z * v[j].z + v[j].w * v[j].w); }
    const float rs = 1.0f / sqrtf(wave_sum(s) * (1.f / DM) + EPS);
    unsigned long long* o8 = (unsigned long long*)orow + lane;
#pragma unroll
    for (int j = 0; j < 8; ++j) { const f32x4 gg = gr[64 * j]; o8[64 * j] = (unsigned long long)pk2(v[j].x * rs * gg.x, v[j].y * rs * gg.y) | ((unsigned long long)pk2(v[j].z * rs * gg.z, v[j].w * rs * gg.w) << 32); }
}

__device__ __forceinline__ void kn_item(Frame& F, unsigned char* QKb, const float* gain, float* kmean, int item) {
    const int isk = item >> 8, b = (item >> 7) & 1, h = (item >> 4) & 7, blk = item & 15;
    const int half = F.lane >> 5, l32 = F.lane & 31;
    const f32x4 gg = *(const f32x4*)(gain + 4 * l32);
    const float post = isk ? 1.0f : QSCALE;
    unsigned char* base = QKb + ((size_t)b * SEQ + blk * 256 + F.wave * 32) * 8192 + (isk ? 4096 : 0) + h * 512;
    f32x4 csum = {0.f, 0.f, 0.f, 0.f};
#pragma unroll 4
    for (int i = 0; i < 16; ++i) {
        unsigned char* rp = base + (size_t)(2 * i + half) * 8192;
        const f32x4 v = *(const f32x4*)(rp + 16 * l32);
        float s = (v.x * v.x + v.y * v.y) + (v.z * v.z + v.w * v.w);
#pragma unroll
        for (int o = 1; o < 32; o <<= 1) s += __shfl_xor(s, o);
        const float rs = post / sqrtf(s * (1.f / HD) + EPS);
        const f32x4 y = {v.x * rs * gg.x, v.y * rs * gg.y, v.z * rs * gg.z, v.w * rs * gg.w};
        csum += y;
        *(unsigned long long*)(rp + 8 * l32) = (unsigned long long)pk2(y.x, y.y) | ((unsigned long long)pk2(y.z, y.w) << 32);
    }
    if (isk) {
        LAS float* red = (LAS float*)F.lds;
        csum.x += __shfl_xor(csum.x, 32); csum.y += __shfl_xor(csum.y, 32); csum.z += __shfl_xor(csum.z, 32); csum.w += __shfl_xor(csum.w, 32);
        if (half == 0) *(LAS f32x4*)(red + F.wave * 128 + 4 * l32) = csum;
        LDS_WAIT(); __syncthreads();
        if (F.tid < 128) { float t = 0.f;
#pragma unroll
            for (int w = 0; w < 8; ++w) t += red[w * 128 + F.tid];
            kmean[((size_t)(b * NHEAD + h) * 16 + blk) * 128 + F.tid] = t * (1.f / 256.f); }
        __syncthreads();
    }
}

constexpr int SG_STRIDE = 272;
__device__ __forceinline__ void sgu_item(Frame& F, const bf16* UG, const float* ln_g, const float* ln_b, const float* w_s, const float* b_s, bf16* MIX, int item) {
    const int g = item & 7, chunk = item >> 3;
    LAS unsigned char* GT = F.lds; LAS unsigned char* WL = F.lds + 128 * SG_STRIDE;
    const size_t row0 = (size_t)chunk * CHUNK;
    {
        const int s = F.tid >> 2, cq = (F.tid & 3) * 32;
        const bf16* gp = UG + (row0 + s) * 2048 + 1024 + g * 128 + cq;
        float x[32];
#pragma unroll
        for (int j = 0; j < 4; ++j) { const v4u w = *(const v4u*)(gp + 8 * j);
#pragma unroll
            for (int e = 0; e < 4; ++e) { x[8 * j + 2 * e] = __uint_as_float(w[e] << 16); x[8 * j + 2 * e + 1] = __uint_as_float(w[e] & 0xffff0000u); } }
        float sm = 0.f;
#pragma unroll
        for (int j = 0; j < 32; ++j) sm += x[j];
        sm += __shfl_xor(sm, 1); sm += __shfl_xor(sm, 2);
        const float mu = sm * (1.f / 128.f); float q = 0.f;
#pragma unroll
        for (int j = 0; j < 32; ++j) { x[j] -= mu; q += x[j] * x[j]; }
        q += __shfl_xor(q, 1); q += __shfl_xor(q, 2);
        const float rs = 1.0f / sqrtf(q * (1.f / 128.f) + EPS);
#pragma unroll
        for (int j = 0; j < 32; ++j) { const float y = x[j] * rs * ln_g[g * 128 + cq + j] + ln_b[g * 128 + cq + j];
            *(LAS unsigned short*)(GT + (cq + j) * SG_STRIDE + 2 * s) = (unsigned short)f2bf(y); }
    }
    {
        const int t = F.tid >> 2, sq = (F.tid & 3) * 32;
        const float* wp = w_s + ((size_t)g * 128 + t) * 128 + sq;
#pragma unroll
        for (int j = 0; j < 4; ++j) { const f32x4 a = *(const f32x4*)(wp + 8 * j), c = *(const f32x4*)(wp + 8 * j + 4); const int s0 = sq + 8 * j;
            v4u o; o.x = pk2(s0 + 0 <= t ? a.x : 0.f, s0 + 1 <= t ? a.y : 0.f); o.y = pk2(s0 + 2 <= t ? a.z : 0.f, s0 + 3 <= t ? a.w : 0.f);
            o.z = pk2(s0 + 4 <= t ? c.x : 0.f, s0 + 5 <= t ? c.y : 0.f); o.w = pk2(s0 + 6 <= t ? c.z : 0.f, s0 + 7 <= t ? c.w : 0.f);
            *(LAS v4u*)(WL + t * SG_STRIDE + 2 * s0) = o; }
    }
    LDS_WAIT(); __syncthreads();
    {
        const int fr = F.lane & 15, fq = F.lane >> 4, w = F.wave;
        f32x4 acc[8];
#pragma unroll
        for (int n = 0; n < 8; ++n) acc[n] = (f32x4){0.f, 0.f, 0.f, 0.f};
        const int ksn = (16 * w + 15) / 32 + 1;
        for (int ks = 0; ks < ksn; ++ks) {
            const bf16x8 bfr = *(const LAS bf16x8*)(WL + (16 * w + fr) * SG_STRIDE + 2 * (32 * ks + 8 * fq));
#pragma unroll
            for (int n = 0; n < 8; ++n) { const bf16x8 afr = *(const LAS bf16x8*)(GT + (16 * n + fr) * SG_STRIDE + 2 * (32 * ks + 8 * fq));
                acc[n] = __builtin_amdgcn_mfma_f32_16x16x32_bf16(afr, bfr, acc[n], 0, 0, 0); }
        }
        const int t = 16 * w + fr; const float bias = b_s[g * 128 + t];
        const bf16* up = UG + (row0 + t) * 2048 + g * 128 + 4 * fq; bf16* op = MIX + (row0 + t) * 2048 + 1024 + g * 128 + 4 * fq;
#pragma unroll
        for (int n = 0; n < 8; ++n) { const unsigned long long uw = *(const unsigned long long*)(up + 16 * n); const unsigned u0 = (unsigned)uw, u1 = (unsigned)(uw >> 32);
            const float o0 = __uint_as_float(u0 << 16) * (acc[n][0] + bias), o1 = __uint_as_float(u0 & 0xffff0000u) * (acc[n][1] + bias);
            const float o2 = __uint_as_float(u1 << 16) * (acc[n][2] + bias), o3 = __uint_as_float(u1 & 0xffff0000u) * (acc[n][3] + bias);
            *(unsigned long long*)(op + 16 * n) = (unsigned long long)pk2(o0, o1) | ((unsigned long long)pk2(o2, o3) << 32); }
    }
    __syncthreads();
}

__device__ __forceinline__ void norm2_row(bf16* row, int lane) {
    v4u* p = (v4u*)row + lane;
#pragma unroll
    for (int hsel = 0; hsel < 2; ++hsel) {
        v4u w[2]; float x[16]; float s = 0.f;
#pragma unroll
        for (int j = 0; j < 2; ++j) { w[j] = p[hsel * 128 + 64 * j];
#pragma unroll
            for (int e = 0; e < 4; ++e) { x[8 * j + 2 * e] = __uint_as_float(w[j][e] << 16); x[8 * j + 2 * e + 1] = __uint_as_float(w[j][e] & 0xffff0000u); } }
#pragma unroll
        for (int j = 0; j < 16; ++j) s += x[j] * x[j];
        const float rs = 1.0f / sqrtf(wave_sum(s) * (1.f / 1024.f) + EPS);
#pragma unroll
        for (int j = 0; j < 2; ++j) { v4u o;
#pragma unroll
            for (int e = 0; e < 4; ++e) o[e] = pk2(x[8 * j + 2 * e] * rs, x[8 * j + 2 * e + 1] * rs);
            p[hsel * 128 + 64 * j] = o; }
    }
}
struct Args { const float* in[20]; float* out; unsigned char* ws; int ph_lo, ph_hi; };
__global__ void __launch_bounds__(NWAVES * 64, 2) hymba_fwd(Args args) {
    extern __shared__ __attribute__((aligned(16))) unsigned char lds[];
    Frame F;
    F.lds = (LAS unsigned char*)lds;
    F.MISC = (volatile LAS unsigned*)(F.lds + MISC_OFF);
    F.tid = threadIdx.x; F.lane = F.tid & 63; F.wave = __builtin_amdgcn_readfirstlane(F.tid >> 6);
    F.G = gridDim.x; { const int bx = blockIdx.x; F.vcu = (F.G % 8 == 0) ? (bx % 8) * (F.G / 8) + bx / 8 : bx; }
    unsigned char* ws = args.ws;
    F.ctl = (gu32*)(ws + WS_CTL);
    const float* x = args.in[0];
    float* out = args.out;
    bf16* W1t = (bf16*)(ws + WS_W1); bf16* W2t = (bf16*)(ws + WS_W2); bf16* Wint = (bf16*)(ws + WS_WIN); bf16* Woutt = (bf16*)(ws + WS_WOUT); bf16* W5t = (bf16*)(ws + WS_W5); bf16* W6t = (bf16*)(ws + WS_W6);
    bf16* XA = (bf16*)(ws + WS_XA); bf16* XB = (bf16*)(ws + WS_XB); bf16* ACT = (bf16*)(ws + WS_ACT);
    float* QK = (float*)(ws + WS_QK); bf16* VB = (bf16*)(ws + WS_V); bf16* UG = (bf16*)(ws + WS_UG); bf16* MIX = (bf16*)(ws + WS_MIX);
    float* SS1 = (float*)(ws + WS_SS1); float* SS2 = (float*)(ws + WS_SS2); float* KMEAN = (float*)(ws + WS_KMEAN);
    for (int u = F.tid; u < (LDS_BYTES - LDSCTL_OFF) / 4; u += NWAVES * 64) ((LAS unsigned*)(F.lds + LDSCTL_OFF))[u] = 0u;
    __syncthreads();
    XcdBarrier bar; bar.bar = (unsigned*)(F.ctl + CW_BAR); bar.x = 0; bar.st = nullptr;
    if (N_LAUNCHES == 1) bar = xcd_barrier_post((unsigned*)(F.ctl + CW_BAR), F.MISC + 8);
    const int lo = args.ph_lo, hi = args.ph_hi;
#define IN(k) (lo <= (k) && (k) < hi)
#define SEAM(k) do { if (IN(k) && IN((k) + 1)) xcd_barrier(bar); } while (0)
    const int gw = F.vcu * NWAVES + F.wave, NGW = F.G * NWAVES;

    if (IN(0)) {
        LAS float* scr = (LAS float*)(F.lds + F.wave * 16384);
        const P0Mat mats[8] = {
            {args.in[2], DM, DFF, W1t, nullptr, 1}, {args.in[3], DM, DFF, W1t, nullptr, 2}, {args.in[4], DFF, DM, W2t, nullptr, 0},
            {args.in[6], DM, DIN, Wint, args.in[5], 0}, {args.in[15], DM, DM, Woutt, nullptr, 3},
            {args.in[17], DM, DFF, W5t, args.in[16], 1}, {args.in[18], DM, DFF, W5t, args.in[16], 2}, {args.in[19], DFF, DM, W6t, nullptr, 0}};
        constexpr int IT_FF = (DM / 64) * (DFF / 32), IT_IN = (DM / 64) * (DIN / 32), IT_OUT = (DM / 64) * (DM / 32);
        constexpr int NITEMS = 6 * IT_FF + IT_IN + IT_OUT;
        for (int m = gw; m < M; m += NGW) rms_row_to_bf16(x + (size_t)m * DM, args.in[1], XA + (size_t)m * DM, F.lane);
        for (int it = gw; it < NITEMS; it += NGW) {
            int r = it, mi = 0;
            const int cnt[8] = {IT_FF, IT_FF, IT_FF, IT_IN, IT_OUT, IT_FF, IT_FF, IT_FF};
#pragma unroll
            for (int k = 0; k < 7; ++k) { if (mi == k && r >= cnt[k]) { r -= cnt[k]; mi = k + 1; } }
            P0Mat mm = mats[0];
#pragma unroll
            for (int k = 1; k < 8; ++k) if (mi == k) mm = mats[k];
            if (mm.mode == 3) {
                const int nblk = DM / 32, kb = r / nblk; const float* kg = (64 * kb < DATT) ? args.in[13] : args.in[14] - DATT;
                p0_transpose_item(mm.W, DM, mm.WT, DM, 64 * kb, 32 * (r % nblk), 32 * (r % nblk), kg, scr, F.lane);
            } else p0_do(mm, r, scr, F.lane);
        }
    }
    SEAM(0);
    if (IN(1)) {
        pg8::Gemm g{XA, W1t, M, N1, DM}; pg8::StaticOrder S; S.init(M, N1, F.G, (int)blockIdx.x);
        pg8::EpiSwiGLU E{ACT, DFF, nullptr};
        pg8::gemm_phase<pg8::EpiSwiGLU, pg8::StaticOrder, true, true>(F.lds, g, S, E);
    }
    SEAM(1);
    if (IN(2)) {
        pg8::Gemm g{ACT, W2t, M, DM, DFF}; pg8::StaticOrder S; S.init(M, DM, F.G, (int)blockIdx.x);
        pg8::EpiResid E{x, out, XB, SS1, 0.5f};
        pg8::gemm_phase<pg8::EpiResid, pg8::StaticOrder, false, true>(F.lds, g, S, E);
    }
    SEAM(2);
    if (IN(3)) {
        pg8::Gemm g{XB, Wint, M, DIN, DM}; pg8::StaticOrder S; S.init(M, DIN, F.G, (int)blockIdx.x);
        pg8::EpiG3 E{QK, VB, UG, SS1};
        pg8::gemm_phase<pg8::EpiG3, pg8::StaticOrder, true, true>(F.lds, g, S, E);
    }
    SEAM(3);
    if (IN(4)) {
        for (int it = F.vcu; it < 512; it += F.G) kn_item(F, (unsigned char*)QK, it < 256 ? args.in[7] : args.in[8], KMEAN, it);
    }
    SEAM(4);
    if (IN(5)) {
        for (int un = F.vcu; un < 256; un += F.G) { const int bh = un >> 4, qb = 15 - (un & 15);
            att::attn_unit(bh >> 3, bh & 7, qb, (const unsigned char*)QK, VB, KMEAN, MIX, F.lds); }
        for (int it = F.vcu; it < 512; it += F.G) sgu_item(F, UG, args.in[9], args.in[10], args.in[11], args.in[12], MIX, it);
    }
    SEAM(5);
    if (IN(6)) { for (int m = gw; m < M; m += NGW) norm2_row(MIX + (size_t)m * 2048, F.lane); }
    SEAM(6);
    if (IN(7)) {
        pg8::Gemm g{MIX, Woutt, M, DM, DM}; pg8::StaticOrder S; S.init(M, DM, F.G, (int)blockIdx.x);
        pg8::EpiResid E{out, out, XA, SS2, 1.0f};
        pg8::gemm_phase<pg8::EpiResid, pg8::StaticOrder, false, true>(F.lds, g, S, E);
    }
    SEAM(7);
    if (IN(8)) {
        pg8::Gemm g{XA, W5t, M, N1, DM}; pg8::StaticOrder S; S.init(M, N1, F.G, (int)blockIdx.x);
        pg8::EpiSwiGLU E{ACT, DFF, SS2};
        pg8::gemm_phase<pg8::EpiSwiGLU, pg8::StaticOrder, true, true>(F.lds, g, S, E);
    }
    SEAM(8);
    if (IN(9)) {
        pg8::Gemm g{ACT, W6t, M, DM, DFF}; pg8::StaticOrder S; S.init(M, DM, F.G, (int)blockIdx.x);
        pg8::EpiResid E{out, out, nullptr, nullptr, 0.5f};
        pg8::gemm_phase<pg8::EpiResid, pg8::StaticOrder, false, true>(F.lds, g, S, E);
    }
#undef IN
#undef SEAM
}

extern "C" void kernel_launch(void* const* d_in, const int* in_sizes, int n_in, void* d_out, int out_size, void* d_ws, size_t ws_size, hipStream_t stream) {
    static int grid = 0;
    if (grid == 0) {
        if (n_in != 20 || in_sizes[0] != M * DM || out_size != M * DM || ws_size < WS_END) { fprintf(stderr, "kernel_launch: shape/workspace mismatch (n_in %d, in0 %d, out %d, ws %zu, need %zu); nothing launched\n", n_in, n_in > 0 ? in_sizes[0] : -1, out_size, ws_size, (size_t)WS_END); grid = -1; return; }
        int dev = 0, cus = 0, per_cu = 0;
        if (hipGetDevice(&dev) != hipSuccess || hipDeviceGetAttribute(&cus, hipDeviceAttributeMultiprocessorCount, dev) != hipSuccess) { grid = -1; return; }
        if (hipFuncSetAttribute((const void*)hymba_fwd, hipFuncAttributeMaxDynamicSharedMemorySize, LDS_BYTES) != hipSuccess) { fprintf(stderr, "kernel_launch: hipFuncSetAttribute failed\n"); grid = -1; return; }
        if (hipOccupancyMaxActiveBlocksPerMultiprocessor(&per_cu, (const void*)hymba_fwd, NWAVES * 64, LDS_BYTES) != hipSuccess || per_cu < 1) { fprintf(stderr, "kernel_launch: occupancy query says %d blocks per CU\n", per_cu); }
        (void)hipGetLastError();
        grid = cus;
        if (grid != 256) fprintf(stderr, "kernel_launch: %d CUs; the residual GEMM phases assume 256 workgroups\n", grid);
    }
    if (grid < 0) return;
    (void)hipMemsetAsync((char*)d_ws + WS_CTL, 0, CTL_ZERO_BYTES, stream);
    Args a{};
    for (int i = 0; i < 20; ++i) a.in[i] = (const float*)d_in[i];
    a.out = (float*)d_out; a.ws = (unsigned char*)d_ws;
    for (int li = 0; li < N_LAUNCHES; ++li) {
        a.ph_lo = (N_LAUNCHES == 1) ? 0 : li; a.ph_hi = (N_LAUNCHES == 1) ? N_PHASES : li + 1;
        hipLaunchKernelGGL(hymba_fwd, dim3(grid), dim3(NWAVES * 64), LDS_BYTES, stream, a);
    }
}
```

```cpp
#include <hip/hip_runtime.h>
#include <cstdio>
#include <cstdint>
__device__ __forceinline__ int mk_lane() { int l; asm volatile("v_mbcnt_lo_u32_b32 %0, -1, 0\n\tv_mbcnt_hi_u32_b32 %0, -1, %0" : "=v"(l)); return l; }
namespace pg8 {
#define PG8_LAS __attribute__((address_space(3)))
typedef unsigned short bf16_t;
typedef short bf16x8 __attribute__((ext_vector_type(8)));
typedef float f32x4 __attribute__((ext_vector_type(4)));
typedef unsigned u32x4 __attribute__((ext_vector_type(4)));
typedef int i32x4 __attribute__((ext_vector_type(4)));
constexpr int BM = 256, BK = 64, HALF = 128, HTB = HALF * BK * 2  , STAGE_BYTES = 8 * HTB, NXCD = 8, WGM = 8;

__host__ __device__ __forceinline__ int lds_byte(int r, int c) { const int st = (r >> 4) * 2 + (c >> 5), rr = r & 15, cc = c & 31, ob = rr * 64 + cc * 2; return st * 1024 + (ob ^ (((ob >> 9) & 1) << 5)); }
__host__ __device__ __forceinline__ void stage_rc(int b, int& R, int& C) { const int st = b / 1024, sb = b % 1024, swz = sb ^ (((sb >> 9) & 1) << 5); R = (st >> 1) * 16 + swz / 64; C = (st & 1) * 32 + (swz % 64) / 2; }
__host__ __device__ __forceinline__ int perm32(int rho) { const int n = rho >> 4, i = rho & 15; return 8 * (i >> 2) + 4 * n + (i & 3); }

struct Unit { int pm, pn; };
struct Gemm { const bf16_t* A; const bf16_t* Bt; int M, N, K; };

struct StaticOrder {
    int nM, nN, nwg, G, c, wgm;
    __host__ __device__ __forceinline__ void init(int M, int N, int G_, int c_, int wgm_ = WGM) { nM = M / BM; nN = N / BM; nwg = nM * nN; G = G_; c = c_; wgm = wgm_; }
    __host__ __device__ __forceinline__ bool next(int i, Unit& u) const {
        const long L = (long)i * G + c; if (L >= nwg) return false;
        int wgid = (int)L; { const int q = nwg / NXCD, r = nwg % NXCD, xcd = wgid % NXCD, off = wgid / NXCD; wgid = (xcd < r ? xcd * (q + 1) : r * (q + 1) + (xcd - r) * q) + off; }
        const int nig = wgm * nN, gid = wgid / nig, fm = gid * wgm, gsz = (nM - fm) < wgm ? (nM - fm) : wgm;
        u.pm = fm + ((wgid % nig) % gsz); u.pn = (wgid % nig) / gsz; return true;
    }
    __device__ __forceinline__ void a_ready(const Unit&) const {}
    __device__ __forceinline__ void done(const Unit&) const {}
};

__device__ __forceinline__ unsigned cvt_pk_bf16(float lo, float hi) { unsigned r; asm volatile("v_cvt_pk_bf16_f32 %0, %1, %2" : "=v"(r) : "v"(lo), "v"(hi)); return r; }
constexpr int DMODEL = 2048;
__device__ __forceinline__ unsigned cvt_pk4_fp8(float a, float b, float c, float d) {
    a = __builtin_amdgcn_fmed3f(a, -448.f, 448.f); b = __builtin_amdgcn_fmed3f(b, -448.f, 448.f); c = __builtin_amdgcn_fmed3f(c, -448.f, 448.f); d = __builtin_amdgcn_fmed3f(d, -448.f, 448.f);
    unsigned w = 0u; w = __builtin_amdgcn_cvt_pk_fp8_f32(a, b, w, false); w = __builtin_amdgcn_cvt_pk_fp8_f32(c, d, w, true); return w;
}
__device__ __forceinline__ float row_rs(const float* ss, int row) {
    const f32x4 a = *(const f32x4*)(ss + (size_t)row * 8), b = *(const f32x4*)(ss + (size_t)row * 8 + 4);
    const float s = ((a[0] + a[1]) + (a[2] + a[3])) + ((b[0] + b[1]) + (b[2] + b[3]));
    return 1.0f / sqrtf(s * (1.0f / DMODEL) + 1e-6f);
}
struct RowScales { float loc[2];
    __device__ __forceinline__ void load(const float* ss, int row0, int fq, float post) {
#pragma unroll
        for (int ai = 0; ai < 2; ++ai) loc[ai] = (ss ? row_rs(ss, row0 + ai * HALF + fq * 16) : 1.0f) * post; }
    __device__ __forceinline__ float get(int ai, int m, int fr) const { return __shfl(loc[ai], fr + 16 * m); }
};
__device__ __forceinline__ float silu_f(float g) { return g * __builtin_amdgcn_rcpf(1.0f + __builtin_amdgcn_exp2f(-1.4426950408889634f * g)); }
__device__ __forceinline__ float gelu_f(float z) { const float t = z * (1.0f + 0.044715f * z * z); return z * __builtin_amdgcn_rcpf(1.0f + __builtin_amdgcn_exp2f(-2.302208198f * t)); }

template <bool OUT8> struct EpiSwiGLU {
    static constexpr bool PERM = true, AFTER_DRAIN = false, MIDK = false;
    bf16_t* O; int ldc; const float* ss; float post;
    __device__ __forceinline__ void operator()(const f32x4 (&acc)[2][2][4][2], const Unit& u, int wr, int wc, int fr, int fq) const {
        const int row0 = u.pm * BM + wr * 64 + fr, col0 = u.pn * HALF + wc * 32 + 8 * fq;
        RowScales rsc; rsc.load(ss, row0, fq, post);
#pragma unroll
        for (int ai = 0; ai < 2; ++ai)
#pragma unroll
            for (int m = 0; m < 4; ++m) { const int row = row0 + ai * HALF + m * 16; const float r = rsc.get(ai, m, fr), c1 = -1.4426950408889634f * r, r2 = r * r;
                float g[8], uu[8], t[8], a[8];
#pragma unroll
                for (int k = 0; k < 8; ++k) { g[k] = acc[ai][0][m][k >> 2][k & 3]; uu[k] = acc[ai][1][m][k >> 2][k & 3]; }
#pragma unroll
                for (int k = 0; k < 8; ++k) t[k] = g[k] * c1;
#pragma unroll
                for (int k = 0; k < 8; ++k) t[k] = __builtin_amdgcn_exp2f(t[k]);
#pragma unroll
                for (int k = 0; k < 8; ++k) t[k] = 1.0f + t[k];
#pragma unroll
                for (int k = 0; k < 8; ++k) t[k] = __builtin_amdgcn_rcpf(t[k]);
#pragma unroll
                for (int k = 0; k < 8; ++k) a[k] = (g[k] * uu[k]) * (t[k] * r2);
                if constexpr (OUT8) { typedef unsigned u32x2v __attribute__((ext_vector_type(2))); u32x2v w; w.x = cvt_pk4_fp8(a[0], a[1], a[2], a[3]); w.y = cvt_pk4_fp8(a[4], a[5], a[6], a[7]);
                    *(u32x2v*)((unsigned char*)O + (size_t)row * ldc + col0) = w; }
                else { u32x4 w; w.x = cvt_pk_bf16(a[0], a[1]); w.y = cvt_pk_bf16(a[2], a[3]); w.z = cvt_pk_bf16(a[4], a[5]); w.w = cvt_pk_bf16(a[6], a[7]);
                    *(u32x4*)(O + (size_t)row * ldc + col0) = w; } }
    }
};
struct EpiG3 {
    static constexpr bool PERM = true, AFTER_DRAIN = false, MIDK = false;
    bf16_t* QKn; bf16_t* V; bf16_t* UG; const float* ss; const float* qg; const float* kg; float* kmean; PG8_LAS unsigned char* xl; float qscale; int pn0; float post;
    __device__ __forceinline__ void operator()(f32x4 (&acc)[2][2][4][2], const Unit& u, int wr, int wc, int fr, int fq) const {
        const int row0 = u.pm * BM + wr * 64 + fr, cw = wc * 32 + 8 * fq, pn = u.pn + pn0;
        RowScales rsc; rsc.load(ss, row0, fq, post);
        if (pn < 8) {
            PG8_LAS float* PS = (PG8_LAS float*)xl;
            PG8_LAS float* KS = (PG8_LAS float*)(xl + 8192);
#pragma unroll
            for (int ai = 0; ai < 2; ++ai)
#pragma unroll
                for (int m = 0; m < 4; ++m) { const float r = rsc.get(ai, m, fr); const int rl = ai * HALF + wr * 64 + m * 16 + fr;
#pragma unroll
                    for (int bj = 0; bj < 2; ++bj) { f32x4 v0 = acc[ai][bj][m][0] * r, v1 = acc[ai][bj][m][1] * r; acc[ai][bj][m][0] = v0; acc[ai][bj][m][1] = v1;
                        float q = ((v0[0] * v0[0] + v0[1] * v0[1]) + (v0[2] * v0[2] + v0[3] * v0[3])) + ((v1[0] * v1[0] + v1[1] * v1[1]) + (v1[2] * v1[2] + v1[3] * v1[3]));
                        q += __shfl_xor(q, 16); q += __shfl_xor(q, 32);
                        if (fq == 0) PS[(rl * 2 + bj) * 4 + wc] = q; } }
            asm volatile("s_waitcnt lgkmcnt(0)" ::: "memory"); __builtin_amdgcn_s_barrier(); asm volatile("" ::: "memory");
            const bool isk = pn >= 4; const float* gp = (isk ? kg : qg) + cw; const f32x4 g0 = *(const f32x4*)gp, g1 = *(const f32x4*)(gp + 4);
            const float post = isk ? 1.0f : qscale;
            f32x4 cs[2][2] = {{{0.f, 0.f, 0.f, 0.f}, {0.f, 0.f, 0.f, 0.f}}, {{0.f, 0.f, 0.f, 0.f}, {0.f, 0.f, 0.f, 0.f}}};
#pragma unroll
            for (int ai = 0; ai < 2; ++ai)
#pragma unroll
                for (int m = 0; m < 4; ++m) { const int rl = ai * HALF + wr * 64 + m * 16 + fr;
#pragma unroll
                    for (int bj = 0; bj < 2; ++bj) { const f32x4 ps = *(const PG8_LAS f32x4*)(PS + (rl * 2 + bj) * 4);
                        const float rs = post / sqrtf(((ps[0] + ps[1]) + (ps[2] + ps[3])) * (1.0f / 128.0f) + 1e-6f);
                        const f32x4 y0 = acc[ai][bj][m][0] * rs * g0, y1 = acc[ai][bj][m][1] * rs * g1;
                        cs[bj][0] += y0; cs[bj][1] += y1;
                        u32x4 w; w.x = cvt_pk_bf16(y0[0], y0[1]); w.y = cvt_pk_bf16(y0[2], y0[3]); w.z = cvt_pk_bf16(y1[0], y1[1]); w.w = cvt_pk_bf16(y1[2], y1[3]);
                        *(u32x4*)(QKn + (size_t)(u.pm * BM + rl) * 2048 + pn * BM + bj * HALF + cw) = w; } }
            if (isk) {
#pragma unroll
                for (int bj = 0; bj < 2; ++bj)
#pragma unroll
                    for (int n = 0; n < 2; ++n)
#pragma unroll
                        for (int j = 0; j < 4; ++j) { float s = cs[bj][n][j]; s += __shfl_xor(s, 1); s += __shfl_xor(s, 2); s += __shfl_xor(s, 4); s += __shfl_xor(s, 8); cs[bj][n][j] = s; }
                if (fr == 0) {
#pragma unroll
                    for (int bj = 0; bj < 2; ++bj) { *(PG8_LAS f32x4*)(KS + wr * 256 + bj * HALF + cw) = cs[bj][0]; *(PG8_LAS f32x4*)(KS + wr * 256 + bj * HALF + cw + 4) = cs[bj][1]; } }
                asm volatile("s_waitcnt lgkmcnt(0)" ::: "memory"); __builtin_amdgcn_s_barrier(); asm volatile("" ::: "memory");
                const int t = (wr * 4 + wc) * 64 + fq * 16 + fr;
                if (t < 256) { const int head = (pn - 4) * 2 + (t >> 7), b = u.pm >> 4, blk = u.pm & 15;
                    kmean[((size_t)(b * 8 + head) * 16 + blk) * 128 + (t & 127)] = (KS[t] + KS[256 + t]) * (1.0f / 256.0f); }
            }
        } else {
#pragma unroll
            for (int ai = 0; ai < 2; ++ai)
#pragma unroll
                for (int m = 0; m < 4; ++m) { const int row = row0 + ai * HALF + m * 16; const float r = rsc.get(ai, m, fr);
#pragma unroll
                    for (int bj = 0; bj < 2; ++bj) { f32x4 v0 = acc[ai][bj][m][0] * r, v1 = acc[ai][bj][m][1] * r;
                        if (pn >= 12) {
#pragma unroll
                            for (int j = 0; j < 4; ++j) { v0[j] = gelu_f(v0[j]); v1[j] = gelu_f(v1[j]); } }
                        u32x4 w; w.x = cvt_pk_bf16(v0[0], v0[1]); w.y = cvt_pk_bf16(v0[2], v0[3]); w.z = cvt_pk_bf16(v1[0], v1[1]); w.w = cvt_pk_bf16(v1[2], v1[3]);
                        bf16_t* p = (pn < 12) ? V + (size_t)row * 1024 + (pn - 8) * BM + bj * HALF + cw : UG + (size_t)row * 2048 + (pn - 12) * BM + bj * HALF + cw;
                        *(u32x4*)p = w; } }
        }
    }
};
struct EpiVUG {
    static constexpr bool PERM = true, AFTER_DRAIN = false, MIDK = false;
    bf16_t* V; bf16_t* UG; const float* ss; float post;
    __device__ __forceinline__ void operator()(const f32x4 (&acc)[2][2][4][2], const Unit& u, int wr, int wc, int fr, int fq) const {
        const int row0 = u.pm * BM + wr * 64 + fr, cw = wc * 32 + 8 * fq, pn = u.pn;
        RowScales rsc; rsc.load(ss, row0, fq, post);
#pragma unroll
        for (int ai = 0; ai < 2; ++ai)
#pragma unroll
            for (int m = 0; m < 4; ++m) { const int row = row0 + ai * HALF + m * 16; const float r = rsc.get(ai, m, fr);
#pragma unroll
                for (int bj = 0; bj < 2; ++bj) { f32x4 v0 = acc[ai][bj][m][0] * r, v1 = acc[ai][bj][m][1] * r;
                    if (pn >= 4) {
#pragma unroll
                        for (int j = 0; j < 4; ++j) { v0[j] = gelu_f(v0[j]); v1[j] = gelu_f(v1[j]); } }
                    u32x4 w; w.x = cvt_pk_bf16(v0[0], v0[1]); w.y = cvt_pk_bf16(v0[2], v0[3]); w.z = cvt_pk_bf16(v1[0], v1[1]); w.w = cvt_pk_bf16(v1[2], v1[3]);
                    bf16_t* p = (pn < 4) ? V + (size_t)row * 1024 + pn * BM + bj * HALF + cw : UG + (size_t)row * 2048 + (pn - 4) * BM + bj * HALF + cw;
                    *(u32x4*)p = w; } }
    }
};
template <bool BASE16, bool MIDK_ = false> struct EpiResid {
    static constexpr bool PERM = true, AFTER_DRAIN = true, MIDK = MIDK_;
    const void* base; float* out; bf16_t* xb; unsigned char* x8; float* ss; float alpha; const PG8_LAS float* tbl;
    __device__ __forceinline__ void midk(f32x4 (&acc)[2][2][4][2], int wr, int fr) const {
#pragma unroll
        for (int ai = 0; ai < 2; ++ai)
#pragma unroll
            for (int m = 0; m < 4; ++m) { const float ra = tbl[(ai * HALF + wr * 64 + m * 16 + fr) * 2];
#pragma unroll
                for (int bj = 0; bj < 2; ++bj)
#pragma unroll
                    for (int n = 0; n < 2; ++n) acc[ai][bj][m][n] *= ra; }
    }
    __device__ __forceinline__ void fused(f32x4 (&acc)[2][2][4][2], const Unit& u, int wr, int wc, int fr, int fq, PG8_LAS unsigned char* lds, int wid, int lane) const {
        typedef unsigned u32x2v __attribute__((ext_vector_type(2)));
        PG8_LAS float* P = (PG8_LAS float*)lds;
        const int col0 = u.pn * BM + wc * 32 + 8 * fq;
#pragma unroll
        for (int ai = 0; ai < 2; ++ai)
#pragma unroll
            for (int m = 0; m < 4; ++m) { const int rl = ai * HALF + wr * 64 + m * 16 + fr; const size_t off = (size_t)(u.pm * BM + rl) * DMODEL + col0; float q = 0.f;
                const float al = MIDK_ ? alpha * tbl[rl * 2 + 1] : alpha;
#pragma unroll
                for (int bj = 0; bj < 2; ++bj) { const size_t o2 = off + bj * HALF; f32x4 b0, b1;
                    if constexpr (BASE16) { const u32x4 w = *(const u32x4*)((const bf16_t*)base + o2);
                        b0 = (f32x4){__uint_as_float(w.x << 16), __uint_as_float(w.x & 0xffff0000u), __uint_as_float(w.y << 16), __uint_as_float(w.y & 0xffff0000u)};
                        b1 = (f32x4){__uint_as_float(w.z << 16), __uint_as_float(w.z & 0xffff0000u), __uint_as_float(w.w << 16), __uint_as_float(w.w & 0xffff0000u)}; }
                    else { b0 = __builtin_nontemporal_load((const f32x4*)((const float*)base + o2)); b1 = __builtin_nontemporal_load((const f32x4*)((const float*)base + o2 + 4)); }
                    const f32x4 v0 = b0 + acc[ai][bj][m][0] * al, v1 = b1 + acc[ai][bj][m][1] * al;
                    if (out) { __builtin_nontemporal_store(v0, (f32x4*)(out + o2)); __builtin_nontemporal_store(v1, (f32x4*)(out + o2 + 4)); }
                    if (xb) { u32x4 w; w.x = cvt_pk_bf16(v0[0], v0[1]); w.y = cvt_pk_bf16(v0[2], v0[3]); w.z = cvt_pk_bf16(v1[0], v1[1]); w.w = cvt_pk_bf16(v1[2], v1[3]); *(u32x4*)(xb + o2) = w; }
                    if (x8) { u32x2v w; w.x = cvt_pk4_fp8(v0[0], v0[1], v0[2], v0[3]); w.y = cvt_pk4_fp8(v1[0], v1[1], v1[2], v1[3]); *(u32x2v*)(x8 + o2) = w; }
                    q += ((v0[0] * v0[0] + v0[1] * v0[1]) + (v0[2] * v0[2] + v0[3] * v0[3])) + ((v1[0] * v1[0] + v1[1] * v1[1]) + (v1[2] * v1[2] + v1[3] * v1[3])); }
                if (ss) { q += __shfl_xor(q, 16); q += __shfl_xor(q, 32); if (fq == 0) P[rl * 4 + wc] = q; }
                if (m == 3) asm volatile("" ::: "memory"); }
        if (ss) {
            asm volatile("s_waitcnt lgkmcnt(0)" ::: "memory"); __builtin_amdgcn_s_barrier(); asm volatile("" ::: "memory");
            const int t = wid * 64 + lane;
            if (t < 256) { const f32x4 p = *(const PG8_LAS f32x4*)(P + t * 4); ss[(size_t)(u.pm * BM + t) * 8 + u.pn] = (p[0] + p[1]) + (p[2] + p[3]); }
        }
    }
};

template <class Epi, class Sched, bool ALIGN_EPI = false, bool SP2 = false, bool F8 = false>
__device__ __forceinline__ void gemm_phase(PG8_LAS unsigned char* lds, const Gemm g, const Sched& S, const Epi& E, const int wid) {
    const int lane = mk_lane(), tid = wid * 64 + lane, wr = wid >> 2, wc = wid & 3, fr = lane & 15, fq = lane >> 4;
    const int K = g.K, nt = K / BK;
    unsigned voffA[2], voffB[2];
#pragma unroll
    for (int i = 0; i < 2; ++i) { int R, C; stage_rc(tid * 16 + i * 8192, R, C); const int Rb = Epi::PERM ? ((R & ~31) + perm32(R & 31)) : R;
        voffA[i] = (unsigned)(R * K + C) * 2u; voffB[i] = (unsigned)(Rb * K + C) * 2u; }
    const unsigned kstep = (unsigned)(BK * 2);
    const unsigned hstep = (unsigned)HALF * K * 2;
    const unsigned tstep = 2 * hstep;
    const unsigned ldsw = (unsigned)wid * 1024u;
    const int aoff = lds_byte(wr * 64 + fr, fq * 8), boff = lds_byte(wc * 32 + fr, fq * 8);
#define PG8_SA(b, h) (((b) * 2 + (h)) * HTB)
#define PG8_SB(b, h) ((4 + (b) * 2 + (h)) * HTB)
    const __amdgpu_buffer_rsrc_t rsA = __builtin_amdgcn_make_buffer_rsrc((void*)g.A, 0, (int)((unsigned)g.M * (unsigned)K * 2u), 0x00020000);
    const __amdgpu_buffer_rsrc_t rsB = __builtin_amdgcn_make_buffer_rsrc((void*)g.Bt, 0, (int)((unsigned)g.N * (unsigned)K * 2u), 0x00020000);
#define PG8_STAGE(bufoff, soff, voff, rs) do { _Pragma("unroll") for (int _i = 0; _i < 2; ++_i) \
        __builtin_amdgcn_raw_ptr_buffer_load_lds(rs, (PG8_LAS void*)(lds + (bufoff) + ldsw + _i * 8192), 16, (int)(voff)[_i], (int)(soff), 0, 0); } while (0)
#define PG8_LDA(dst, b, h) do { _Pragma("unroll") for (int m = 0; m < 4; ++m) _Pragma("unroll") for (int k = 0; k < 2; ++k) dst[m][k] = *(const PG8_LAS bf16x8*)(lds + PG8_SA(b, h) + aoff + m * 2048 + k * 1024); } while (0)
#define PG8_LDB(dst, b, h) do { _Pragma("unroll") for (int n = 0; n < 2; ++n) _Pragma("unroll") for (int k = 0; k < 2; ++k) dst[n][k] = *(const PG8_LAS bf16x8*)(lds + PG8_SB(b, h) + boff + n * 2048 + k * 1024); } while (0)
#define PG8_CAT(v) __builtin_shufflevector(__builtin_bit_cast(i32x4, (v)[0]), __builtin_bit_cast(i32x4, (v)[1]), 0, 1, 2, 3, 4, 5, 6, 7)
#define PG8_MMA(ai, bj, At, Bt) do { __builtin_amdgcn_s_setprio(1); if constexpr (F8) { _Pragma("unroll") for (int m = 0; m < 4; ++m) _Pragma("unroll") for (int n = 0; n < 2; ++n) \
        acc[ai][bj][m][n] = __builtin_amdgcn_mfma_scale_f32_16x16x128_f8f6f4(PG8_CAT(Bt[n]), PG8_CAT(At[m]), acc[ai][bj][m][n], 0, 0, 0, 0, 0, 0); } else { \
        _Pragma("unroll") for (int m = 0; m < 4; ++m) _Pragma("unroll") for (int n = 0; n < 2; ++n) _Pragma("unroll") for (int k = 0; k < 2; ++k) \
        acc[ai][bj][m][n] = __builtin_amdgcn_mfma_f32_16x16x32_bf16(Bt[n][k], At[m][k], acc[ai][bj][m][n], 0, 0, 0); } __builtin_amdgcn_s_setprio(0); } while (0)
#define PG8_WAIT_V(n) asm volatile("s_waitcnt vmcnt(" #n ")" ::: "memory")
#define PG8_WAIT_L(n) asm volatile("s_waitcnt lgkmcnt(" #n ")" ::: "memory")
#define PG8_BAR __builtin_amdgcn_s_barrier()
#define PG8_SCHED __builtin_amdgcn_sched_barrier(0)
    Unit cur, nxt; int ui = 0;
    if (!S.next(0, cur)) return;
    f32x4 acc[2][2][4][2];
#pragma unroll
    for (int a = 0; a < 2; ++a)
#pragma unroll
        for (int b = 0; b < 2; ++b)
#pragma unroll
            for (int m = 0; m < 4; ++m)
#pragma unroll
                for (int n = 0; n < 2; ++n) acc[a][b][m][n] = (f32x4){0.f, 0.f, 0.f, 0.f};
    bf16x8 At[4][2], B0[2][2], B1[2][2];
    unsigned cA = (unsigned)cur.pm * tstep, cB = (unsigned)cur.pn * tstep;
    S.a_ready(cur);
    if constexpr (SP2) {
        PG8_STAGE(PG8_SB(0, 0), cB, voffB, rsB); PG8_STAGE(PG8_SB(0, 1), cB + hstep, voffB, rsB); PG8_STAGE(PG8_SA(0, 0), cA, voffA, rsA); PG8_STAGE(PG8_SA(0, 1), cA + hstep, voffA, rsA);
        if (wr == 1) PG8_BAR;
        PG8_WAIT_V(2); PG8_BAR;
        PG8_STAGE(PG8_SB(1, 0), cB + kstep, voffB, rsB); PG8_STAGE(PG8_SA(1, 0), cA + kstep, voffA, rsA); PG8_STAGE(PG8_SB(1, 1), cB + hstep + kstep, voffB, rsB);
        PG8_WAIT_V(6); PG8_BAR;
    } else {
        PG8_STAGE(PG8_SB(0, 0), cB, voffB, rsB); PG8_STAGE(PG8_SA(0, 0), cA, voffA, rsA); PG8_STAGE(PG8_SB(0, 1), cB + hstep, voffB, rsB); PG8_STAGE(PG8_SA(0, 1), cA + hstep, voffA, rsA);
        if (wr == 1) PG8_BAR;
        PG8_WAIT_V(4); PG8_BAR;
        PG8_STAGE(PG8_SB(1, 0), cB + kstep, voffB, rsB); PG8_STAGE(PG8_SA(1, 0), cA + kstep, voffA, rsA); PG8_STAGE(PG8_SB(1, 1), cB + hstep + kstep, voffB, rsB);
        PG8_WAIT_V(6); PG8_BAR;
    }
    for (;;) {
        const bool has_next = S.next(ui + 1, nxt);
        const unsigned nA = has_next ? (unsigned)nxt.pm * tstep : cA, nB = has_next ? (unsigned)nxt.pn * tstep : cB;
        for (int t = 0; t < nt; t += 2) {
            if constexpr (Epi::MIDK) { if (t == (nt >> 1)) E.midk(acc, wr, mk_lane() & 15); }
            const bool last = (t == nt - 2);
            const unsigned a1 = cA + (unsigned)(t + 1) * kstep;
            const unsigned a2 = last ? nA : cA + (unsigned)(t + 2) * kstep, b2 = last ? nB : cB + (unsigned)(t + 2) * kstep;
            const unsigned a3 = a2 + kstep, b3 = b2 + kstep;
            if (last && has_next) S.a_ready(nxt);
            if constexpr (SP2) {
            PG8_LDB(B0, 0, 0); PG8_LDB(B1, 0, 1); PG8_SCHED; PG8_LDA(At, 0, 0); PG8_STAGE(PG8_SA(1, 1), a1 + hstep, voffA, rsA);
            PG8_WAIT_V(8); PG8_WAIT_L(0); PG8_BAR; PG8_MMA(0, 0, At, B0); PG8_MMA(0, 1, At, B1); PG8_BAR; PG8_SCHED;
            PG8_LDA(At, 0, 1); PG8_STAGE(PG8_SB(0, 0), b2, voffB, rsB); PG8_STAGE(PG8_SB(0, 1), b2 + hstep, voffB, rsB); PG8_STAGE(PG8_SA(0, 0), a2, voffA, rsA);
            PG8_WAIT_V(8); PG8_WAIT_L(0); PG8_BAR; PG8_MMA(1, 0, At, B0); PG8_MMA(1, 1, At, B1); PG8_BAR; PG8_SCHED;
            PG8_LDB(B0, 1, 0); PG8_LDB(B1, 1, 1); PG8_SCHED; PG8_LDA(At, 1, 0); PG8_STAGE(PG8_SA(0, 1), a2 + hstep, voffA, rsA);
            PG8_WAIT_V(8); PG8_WAIT_L(0); PG8_BAR; PG8_MMA(0, 0, At, B0); PG8_MMA(0, 1, At, B1); PG8_BAR; PG8_SCHED;
            PG8_LDA(At, 1, 1); PG8_STAGE(PG8_SB(1, 0), b3, voffB, rsB); PG8_STAGE(PG8_SB(1, 1), b3 + hstep, voffB, rsB); PG8_STAGE(PG8_SA(1, 0), a3, voffA, rsA);
            PG8_WAIT_V(8); PG8_WAIT_L(0); PG8_BAR; PG8_MMA(1, 0, At, B0); PG8_MMA(1, 1, At, B1); PG8_BAR; PG8_SCHED;
            } else {
            PG8_LDB(B0, 0, 0); PG8_SCHED; PG8_LDA(At, 0, 0); PG8_STAGE(PG8_SA(1, 1), a1 + hstep, voffA, rsA);
            PG8_WAIT_L(8); PG8_BAR; PG8_WAIT_L(0); PG8_MMA(0, 0, At, B0); PG8_BAR; PG8_SCHED;
            PG8_LDB(B1, 0, 1); PG8_STAGE(PG8_SB(0, 0), b2, voffB, rsB);
            PG8_BAR; PG8_WAIT_L(0); PG8_MMA(0, 1, At, B1); PG8_BAR;
            PG8_LDA(At, 0, 1); PG8_STAGE(PG8_SA(0, 0), a2, voffA, rsA);
            PG8_BAR; PG8_WAIT_L(0); PG8_MMA(1, 0, At, B0); PG8_BAR; PG8_SCHED;
            PG8_STAGE(PG8_SB(0, 1), b2 + hstep, voffB, rsB);
            PG8_WAIT_V(6); PG8_BAR; PG8_MMA(1, 1, At, B1); PG8_BAR;
            PG8_LDB(B0, 1, 0); PG8_SCHED; PG8_LDA(At, 1, 0); PG8_STAGE(PG8_SA(0, 1), a2 + hstep, voffA, rsA);
            PG8_WAIT_L(8); PG8_BAR; PG8_WAIT_L(0); PG8_MMA(0, 0, At, B0); PG8_BAR; PG8_SCHED;
            PG8_LDB(B1, 1, 1); PG8_STAGE(PG8_SB(1, 0), b3, voffB, rsB);
            PG8_BAR; PG8_WAIT_L(0); PG8_MMA(0, 1, At, B1); PG8_BAR;
            PG8_LDA(At, 1, 1); PG8_STAGE(PG8_SA(1, 0), a3, voffA, rsA);
            PG8_BAR; PG8_WAIT_L(0); PG8_MMA(1, 0, At, B0); PG8_BAR; PG8_SCHED;
            PG8_STAGE(PG8_SB(1, 1), b3 + hstep, voffB, rsB);
            PG8_WAIT_V(6); PG8_BAR; PG8_MMA(1, 1, At, B1); PG8_BAR;
            }
        }
        if constexpr (ALIGN_EPI) { if (wr == 0) PG8_BAR; }
        if constexpr (!Epi::AFTER_DRAIN) { const int l2_ = mk_lane(); E(acc, cur, wr, wc, l2_ & 15, l2_ >> 4); S.done(cur); }
        if (!has_next) break;
#pragma unroll
        for (int a = 0; a < 2; ++a)
#pragma unroll
            for (int b = 0; b < 2; ++b)
#pragma unroll
                for (int m = 0; m < 4; ++m)
#pragma unroll
                    for (int n = 0; n < 2; ++n) acc[a][b][m][n] = (f32x4){0.f, 0.f, 0.f, 0.f};
        cur = nxt; cA = nA; cB = nB; ++ui;
        if constexpr (ALIGN_EPI) { if (wr == 1) PG8_BAR; }
    }
    PG8_WAIT_V(0);
    if constexpr (!ALIGN_EPI) { if (wr == 0) PG8_BAR; }
    PG8_BAR;
    if constexpr (Epi::AFTER_DRAIN) { const int l2_ = mk_lane(); E.fused(acc, cur, wr, wc, l2_ & 15, l2_ >> 4, lds, wid, l2_); S.done(cur); }
#undef PG8_SA
#undef PG8_SB
#undef PG8_STAGE
#undef PG8_LDA
#undef PG8_LDB
#undef PG8_MMA
#undef PG8_CAT
#undef PG8_WAIT_V
#undef PG8_WAIT_L
#undef PG8_BAR
#undef PG8_SCHED
}
}

namespace att {
#define ALDS __attribute__((address_space(3)))
typedef short bf16x8 __attribute__((ext_vector_type(8)));
typedef short s16x4 __attribute__((ext_vector_type(4)));
typedef float f32x16 __attribute__((ext_vector_type(16)));
typedef float f32x4 __attribute__((ext_vector_type(4)));
typedef unsigned u32x4 __attribute__((ext_vector_type(4)));
constexpr int NW = 8, QBLK = 32, KVBLK = 64, D = 128, SEQ = 4096, NHEAD = 8;
constexpr int SHM_V = KVBLK * D * 2, SHM_K = KVBLK * D * 2;
constexpr int OFF_V = 0, OFF_K = 2 * SHM_V, OFF_WS = 2 * SHM_V + 2 * SHM_K, ATT_LDS = OFF_WS + NW * 64 * 4;
constexpr size_t QK_PITCH = 4096;
#define KSWZ(row, colB) ((row) * 256 + ((colB) ^ (((row) & 7) << 4)))
#define SBAR() __builtin_amdgcn_sched_barrier(0)
__device__ __forceinline__ int v_st(int k, int c) { const int kk = (k & ~0xC) | ((k & 4) << 1) | ((k & 8) >> 1); return ((kk >> 3) * 4 + (c >> 5)) * 512 + ((kk & 7) * 32 + (c & 31)) * 2; }
__device__ __forceinline__ int v_rd_base(int lane) { return ((lane & 3) << 3) | (((lane >> 2) & 3) << 6) | (((lane >> 4) & 1) << 5) | (((lane >> 5) & 1) << 8); }
constexpr int v_rd_off(int d0, int ks, int half) { return d0 * 512 + ks * 4096 + half * 2048; }
__device__ __forceinline__ int crow(int r, int hi) { return (r & 3) + 8 * (r >> 2) + 4 * hi; }
__device__ __forceinline__ unsigned cvtpk(float lo, float hi) { unsigned r; asm volatile("v_cvt_pk_bf16_f32 %0, %1, %2" : "=v"(r) : "v"(lo), "v"(hi)); return r; }
constexpr float THR2 = 11.5f;

__device__ __forceinline__ void partialSM(f32x16& p0, f32x16& p1, float& m_reg, float& alpha) {
    float pmax = p0[0];
#pragma unroll
    for (int r = 1; r < 16; ++r) pmax = fmaxf(pmax, p0[r]);
#pragma unroll
    for (int r = 0; r < 16; ++r) pmax = fmaxf(pmax, p1[r]);
    { auto rr = __builtin_amdgcn_permlane32_swap(__float_as_uint(pmax), __float_as_uint(pmax), false, false);
      pmax = fmaxf(__uint_as_float(rr[0]), __uint_as_float(rr[1])); }
    alpha = 1.f;
    if (__builtin_expect(!__all(pmax <= THR2), 0)) { const float dl = fmaxf(pmax, 0.f); alpha = __builtin_amdgcn_exp2f(-dl); m_reg += dl;
#pragma unroll
        for (int r = 0; r < 16; ++r) { p0[r] -= dl; p1[r] -= dl; } }
#pragma unroll
    for (int r = 0; r < 16; ++r) p0[r] = __builtin_amdgcn_exp2f(p0[r]);
#pragma unroll
    for (int r = 0; r < 16; ++r) p1[r] = __builtin_amdgcn_exp2f(p1[r]);
}
__device__ __forceinline__ void finishSM(f32x16& p0, f32x16& p1, float alpha, float& l_reg, bf16x8& pa0, bf16x8& pa1, bf16x8& pa2, bf16x8& pa3) {
    float ps = 0;
#pragma unroll
    for (int r = 0; r < 16; ++r) ps += p0[r];
#pragma unroll
    for (int r = 0; r < 16; ++r) ps += p1[r];
    { auto rr = __builtin_amdgcn_permlane32_swap(__float_as_uint(ps), __float_as_uint(ps), false, false);
      ps = __uint_as_float(rr[0]) + __uint_as_float(rr[1]); }
    l_reg = l_reg * alpha + ps;
#define PK4(P, B_, OUT) do { unsigned a0 = cvtpk(P[B_+0], P[B_+1]), a1 = cvtpk(P[B_+2], P[B_+3]);                          \
        unsigned b0 = cvtpk(P[B_+4], P[B_+5]), b1 = cvtpk(P[B_+6], P[B_+7]);                                             \
        auto r0 = __builtin_amdgcn_permlane32_swap(a0, b0, false, false); auto r1 = __builtin_amdgcn_permlane32_swap(a1, b1, false, false); \
        u32x4 w = {r0[0], r1[0], r0[1], r1[1]}; OUT = __builtin_bit_cast(bf16x8, w); } while (0)
    PK4(p0, 0, pa0); PK4(p0, 8, pa1); PK4(p1, 0, pa2); PK4(p1, 8, pa3);
#undef PK4
}
__device__ __forceinline__ void qkt(f32x16& p0, f32x16& p1, const ALDS char* Kt, int r32, int hi, const bf16x8* qr, float c0) {
#pragma unroll
    for (int r = 0; r < 16; ++r) { p0[r] = c0; p1[r] = c0; }
    const ALDS char* kb[4];
#pragma unroll
    for (int dd = 0; dd < 4; ++dd) kb[dd] = Kt + KSWZ(r32, (dd * 16 + hi * 8) * 2);
    __builtin_amdgcn_s_setprio(1);
#pragma unroll
    for (int d0 = 0; d0 < 8; ++d0) { const ALDS char* a = kb[d0 & 3] + (d0 >> 2) * 128;
        bf16x8 b0 = *reinterpret_cast<const ALDS bf16x8*>(a);
        bf16x8 b1 = *reinterpret_cast<const ALDS bf16x8*>(a + 32 * 256);
        p0 = __builtin_amdgcn_mfma_f32_32x32x16_bf16(b0, qr[d0], p0, 0, 0, 0);
        p1 = __builtin_amdgcn_mfma_f32_32x32x16_bf16(b1, qr[d0], p1, 0, 0, 0); }
    __builtin_amdgcn_s_setprio(0);
}
__device__ __forceinline__ void pv_tile(f32x16* o, int vb, bf16x8 pa0, bf16x8 pa1, bf16x8 pa2, bf16x8 pa3) {
#define TRRD(dst, off) asm volatile("ds_read_b64_tr_b16 %0, %1 offset:%2" : "=&v"(dst) : "v"(vb), "i"(off) : "memory")
#define PV_D0(d0) do { s16x4 l0, l1, l2, l3, h0, h1, h2, h3; constexpr int b_ = v_rd_off(d0, 0, 0); \
        TRRD(l0, b_); TRRD(h0, b_ + 2048); TRRD(l1, b_ + 4096); TRRD(h1, b_ + 6144); TRRD(l2, b_ + 8192); TRRD(h2, b_ + 10240); TRRD(l3, b_ + 12288); TRRD(h3, b_ + 14336); \
        asm volatile("s_waitcnt lgkmcnt(0)" ::: "memory"); SBAR();   \
        o[d0] = __builtin_amdgcn_mfma_f32_32x32x16_bf16(pa0, (bf16x8){l0[0], l0[1], l0[2], l0[3], h0[0], h0[1], h0[2], h0[3]}, o[d0], 0, 0, 0);   \
        o[d0] = __builtin_amdgcn_mfma_f32_32x32x16_bf16(pa1, (bf16x8){l1[0], l1[1], l1[2], l1[3], h1[0], h1[1], h1[2], h1[3]}, o[d0], 0, 0, 0);   \
        o[d0] = __builtin_amdgcn_mfma_f32_32x32x16_bf16(pa2, (bf16x8){l2[0], l2[1], l2[2], l2[3], h2[0], h2[1], h2[2], h2[3]}, o[d0], 0, 0, 0);   \
        o[d0] = __builtin_amdgcn_mfma_f32_32x32x16_bf16(pa3, (bf16x8){l3[0], l3[1], l3[2], l3[3], h3[0], h3[1], h3[2], h3[3]}, o[d0], 0, 0, 0); } while (0)
    __builtin_amdgcn_s_setprio(1); PV_D0(0); PV_D0(1); PV_D0(2); PV_D0(3); __builtin_amdgcn_s_setprio(0);
#undef PV_D0
#undef TRRD
}

constexpr int GRP_LDS = 65536;
constexpr int OFF_SCR = 133120;
__device__ __forceinline__ void attn_unit(int b, int h, int qb, int half, const unsigned char* QKb, const unsigned short* Vb, const float* kmean, unsigned short* O, float* ssa, ALDS unsigned char* lds, int wid) {
    const int lane = mk_lane(), r32 = lane & 31, hi = lane >> 5, grp = wid >> 2, wq = wid & 3, tg = wq * 64 + lane;
    const size_t rowbase = (size_t)b * SEQ;
    const int rblk = half * 128 + wq * QBLK;
    const int qw = qb * 256 + rblk;
    ALDS char* V_lds = (ALDS char*)lds + grp * GRP_LDS; ALDS char* K_lds = V_lds + 2 * SHM_V;
    ALDS float* ws = (ALDS float*)(lds + OFF_SCR) + wid * 64; ALDS float* li_l = ws; ALDS float* al_l = ws + 32;
    const int n_own = 2 * (half + 1), NT = n_own + 4 * qb, NIT = NT >> 1;
    const int sr = tg >> 4, sc = (tg & 15) * 8, kws = KSWZ(sr, sc * 2);
    int vst[4];
#pragma unroll
    for (int j = 0; j < 4; ++j) vst[j] = v_st(sr + 16 * j, sc);
    const int vb0 = (int)(uintptr_t)V_lds + v_rd_base(lane);
    const unsigned char* Kg = QKb + 2048 + h * 256 + sc * 2 + (rowbase + sr) * QK_PITCH;
    const unsigned short* Vg = Vb + (rowbase + sr) * 1024 + h * 128 + sc;
    float m_reg = 0.f, l_reg = 0.f; f32x16 o[4] = {};
    bf16x8 st_k[4], st_v[4];
#define KEY0(s) ((s) < n_own ? qb * 256 + 64 * (s) : ((s) - n_own) * 64)
#define SLOAD(s) do { const size_t k0_ = (size_t)KEY0(s); _Pragma("unroll") for (int j_ = 0; j_ < 4; ++j_) { st_k[j_] = *(const bf16x8*)(Kg + (k0_ + 16 * j_) * QK_PITCH); st_v[j_] = *(const bf16x8*)(Vg + (k0_ + 16 * j_) * 1024); } } while (0)
#define SWRITE(bf) do { _Pragma("unroll") for (int j_ = 0; j_ < 4; ++j_) { *(ALDS bf16x8*)(K_lds + (bf) * SHM_K + kws + j_ * 16 * 256) = st_k[j_]; *(ALDS bf16x8*)(V_lds + (bf) * SHM_V + vst[j_]) = st_v[j_]; } } while (0)
    SLOAD(grp);
    bf16x8 qr[8];
    { const unsigned char* qp = QKb + (rowbase + qw + r32) * QK_PITCH + h * 256 + hi * 16;
#pragma unroll
      for (int d0 = 0; d0 < 8; ++d0) qr[d0] = *(const bf16x8*)(qp + d0 * 32); }
    unsigned selmask = 0u;
    if (qb > 0) {
        f32x16 g = f32x16{};
        const float* km = kmean + ((size_t)(b * NHEAD + h) * 16 + (r32 & 15)) * 128 + hi * 8;
#pragma unroll
        for (int d0 = 0; d0 < 8; ++d0) {
            f32x4 a = *(const f32x4*)(km + d0 * 16), c = *(const f32x4*)(km + d0 * 16 + 4);
            if (r32 >= 16) { a = (f32x4){0.f, 0.f, 0.f, 0.f}; c = a; }
            u32x4 wh = {cvtpk(a[0], a[1]), cvtpk(a[2], a[3]), cvtpk(c[0], c[1]), cvtpk(c[2], c[3])};
            f32x4 ra, rc;
#pragma unroll
            for (int j = 0; j < 2; ++j) { ra[2 * j] = a[2 * j] - __uint_as_float(wh[j] << 16); ra[2 * j + 1] = a[2 * j + 1] - __uint_as_float(wh[j] & 0xffff0000u);
                                          rc[2 * j] = c[2 * j] - __uint_as_float(wh[2 + j] << 16); rc[2 * j + 1] = c[2 * j + 1] - __uint_as_float(wh[2 + j] & 0xffff0000u); }
            u32x4 wl = {cvtpk(ra[0], ra[1]), cvtpk(ra[2], ra[3]), cvtpk(rc[0], rc[1]), cvtpk(rc[2], rc[3])};
            g = __builtin_amdgcn_mfma_f32_32x32x16_bf16(__builtin_bit_cast(bf16x8, wh), qr[d0], g, 0, 0, 0);
            g = __builtin_amdgcn_mfma_f32_32x32x16_bf16(__builtin_bit_cast(bf16x8, wl), qr[d0], g, 0, 0, 0);
        }
        float v[8];
#pragma unroll
        for (int r = 0; r < 8; ++r) { const int n = crow(r, hi); v[r] = (n < qb) ? g[r] : -3.0e38f; }
        const int rounds = qb < 3 ? qb : 3;
#pragma unroll
        for (int rd = 0; rd < 3; ++rd) if (rd < rounds) {
            float bv = v[0]; int bi = crow(0, hi);
#pragma unroll
            for (int r = 1; r < 8; ++r) { if (v[r] > bv) { bv = v[r]; bi = crow(r, hi); } }
            const float ov = __shfl_xor(bv, 32); const int oi = __shfl_xor(bi, 32);
            const bool mine = (bv > ov) || (bv == ov && bi < oi);
            const int wi = mine ? bi : oi;
            selmask |= 1u << wi;
#pragma unroll
            for (int r = 0; r < 8; ++r) if (crow(r, hi) == wi) v[r] = -3.0e38f;
        }
    }
    SWRITE(0); __syncthreads();
    const float NEG = -__builtin_inff();
    for (int it = 0; it < NIT; ++it) {
        const int bf = it & 1, s = 2 * it + grp;
        if (it + 1 < NIT) SLOAD(s + 2);
        f32x16 p0, p1;
        const bool keep = (s < n_own) || ((selmask >> ((s - n_own) >> 2)) & 1u);
        qkt(p0, p1, K_lds + bf * SHM_K, r32, hi, qr, keep ? -m_reg : NEG);
        if (s < n_own && 64 * s + 63 > rblk) {
            const int dq = rblk + r32 - 64 * s - 4 * hi;
#pragma unroll
            for (int r = 0; r < 16; ++r) { const int c = (r & 3) + 8 * (r >> 2); if (c > dq) p0[r] = NEG; if (c + 32 > dq) p1[r] = NEG; } }
        float alpha; bf16x8 pa0, pa1, pa2, pa3;
        partialSM(p0, p1, m_reg, alpha);
        finishSM(p0, p1, alpha, l_reg, pa0, pa1, pa2, pa3);
        if (__any(alpha < 1.f)) { if (hi == 0) al_l[r32] = alpha; asm volatile("s_waitcnt lgkmcnt(0)" ::: "memory");
#pragma unroll
            for (int d_ = 0; d_ < 4; ++d_)
#pragma unroll
                for (int r = 0; r < 16; ++r) o[d_][r] *= al_l[crow(r, hi)]; }
        pv_tile(o, vb0 + bf * SHM_V, pa0, pa1, pa2, pa3);
        if (it + 1 < NIT) SWRITE(bf ^ 1);
        __syncthreads();
    }
#undef SLOAD
#undef SWRITE
#undef KEY0
    ALDS float* ex = (ALDS float*)lds + wq * 4096;
    ALDS float* exml = (ALDS float*)(lds + OFF_SCR) + (wq + 4) * 64;
    if (grp == 1) {
        if (hi == 0) { exml[r32] = m_reg; exml[32 + r32] = l_reg; }
#pragma unroll
        for (int d0 = 0; d0 < 4; ++d0)
#pragma unroll
            for (int r = 0; r < 16; ++r) ex[(d0 * 16 + r) * 64 + lane] = o[d0][r];
    }
    asm volatile("s_waitcnt lgkmcnt(0)" ::: "memory"); __syncthreads();
    if (grp == 0) {
        const float m1 = exml[r32], l1 = exml[32 + r32];
        const float mm = fmaxf(m_reg, m1), a0 = __builtin_amdgcn_exp2f(m_reg - mm), a1 = __builtin_amdgcn_exp2f(m1 - mm);
        const float inv = 1.0f / (l_reg * a0 + l1 * a1);
        if (hi == 0) { li_l[r32] = a0 * inv; al_l[r32] = a1 * inv; }
        asm volatile("s_waitcnt lgkmcnt(0)" ::: "memory");
        float f0[16], f1[16];
#pragma unroll
        for (int r = 0; r < 16; ++r) { f0[r] = li_l[crow(r, hi)]; f1[r] = al_l[crow(r, hi)]; }
#pragma unroll
        for (int d0 = 0; d0 < 4; ++d0)
#pragma unroll
            for (int r = 0; r < 16; ++r) o[d0][r] = o[d0][r] * f0[r] + ex[(d0 * 16 + r) * 64 + lane] * f1[r];
    }
    asm volatile("s_waitcnt lgkmcnt(0)" ::: "memory"); __syncthreads();
    if (grp == 0) {
        ALDS unsigned char* stg = (ALDS unsigned char*)(lds + wq * 4096);
#pragma unroll
        for (int r = 0; r < 16; ++r) { const int orow = crow(r, hi);
#pragma unroll
            for (int d0 = 0; d0 < 4; ++d0) { const unsigned w = pg8::cvt_pk4_fp8(16.0f * o[d0][r], 0.f, 0.f, 0.f); stg[orow * 128 + d0 * 32 + r32] = (unsigned char)(w & 0xffu); } }
        asm volatile("s_waitcnt lgkmcnt(0)" ::: "memory");
        unsigned char* Ow = (unsigned char*)O + (rowbase + qw) * 2048 + h * 128;
#pragma unroll
        for (int i = 0; i < 4; ++i) { const int row = i * 8 + (lane >> 3), ch = lane & 7; const u32x4 v = *(const ALDS u32x4*)(stg + row * 128 + ch * 16); *(u32x4*)(Ow + (size_t)row * 2048 + ch * 16) = v;
            float q = 0.f;
#pragma unroll
            for (int e2 = 0; e2 < 4; ++e2) { const float x0 = __builtin_amdgcn_cvt_f32_fp8((int)v[e2], 0), x1 = __builtin_amdgcn_cvt_f32_fp8((int)v[e2], 1), x2 = __builtin_amdgcn_cvt_f32_fp8((int)v[e2], 2), x3 = __builtin_amdgcn_cvt_f32_fp8((int)v[e2], 3);
                q += (x0 * x0 + x1 * x1) + (x2 * x2 + x3 * x3); }
            q += __shfl_xor(q, 1); q += __shfl_xor(q, 2); q += __shfl_xor(q, 4);
            if (ch == 0) ssa[(rowbase + qw + row) * 8 + h] = q; }
    }
    __syncthreads();
}
#undef KSWZ
#undef SBAR
#undef ALDS
}

#define GAS __attribute__((address_space(1)))
#define LAS __attribute__((address_space(3)))
typedef unsigned short bf16;
typedef unsigned v4u __attribute__((ext_vector_type(4)));
typedef float f32x4 __attribute__((ext_vector_type(4)));
typedef short bf16x8 __attribute__((ext_vector_type(8)));
typedef GAS unsigned gu32;
typedef GAS unsigned long long gu64;
#define RLX_AGENT __ATOMIC_RELAXED, __HIP_MEMORY_SCOPE_AGENT
#define LDS_WAIT() asm volatile("s_waitcnt lgkmcnt(0)" ::: "memory")
#define VM_WAIT() asm volatile("s_waitcnt vmcnt(0)" ::: "memory")
__device__ __forceinline__ unsigned long long rt() { return __builtin_amdgcn_s_memrealtime(); }
__device__ __forceinline__ unsigned f2bf(float f) { unsigned u = __builtin_bit_cast(unsigned, f); return (u + 0x7fffu + ((u >> 16) & 1u)) >> 16; }
__device__ __forceinline__ unsigned pk2(float lo, float hi) { return f2bf(lo) | (f2bf(hi) << 16); }

#define XB_TMO      128
#define XB_XCNT(j)  (256  + 64 * (j))
#define XB_XSUB(j)  (1280 + 64 * (j))
#define XB_XGEN(j)  (2304 + 64 * (j))
#define XB_TOP      3328
#define XB_TOPGEN   3392
#define XCD_BAR_WORDS 3456
#define XB_SPIN_CAP (1u << 18)

__device__ __forceinline__ unsigned xb_ld(unsigned* p)              { return __hip_atomic_load(p, __ATOMIC_RELAXED, __HIP_MEMORY_SCOPE_AGENT); }
__device__ __forceinline__ unsigned xb_add(unsigned* p, unsigned v) { return __hip_atomic_fetch_add(p, v, __ATOMIC_RELAXED, __HIP_MEMORY_SCOPE_AGENT); }
__device__ __forceinline__ unsigned xb_xcc_id() { return (unsigned)__builtin_amdgcn_s_getreg((3 << 11) | 20) & 0xFu; }
#define XB_SPIN(cond, bar) do { unsigned _sp = 0; while (cond) { __builtin_amdgcn_s_sleep(1); \
    if ((++_sp & 255u) == 0u) { if (xb_ld(&(bar)[XB_TMO])) break; if (_sp > XB_SPIN_CAP) { atomicAdd(&(bar)[XB_TMO], 1u); break; } } } } while (0)

struct XcdBarrier {
    unsigned* bar; unsigned x;
    volatile LAS unsigned* st;
};

__device__ __forceinline__ XcdBarrier xcd_barrier_post(unsigned* bar, volatile LAS unsigned* st, bool t0) {
    XcdBarrier b; b.bar = bar; b.x = xb_xcc_id(); b.st = st;
    if (t0) (void)xb_add(&bar[XB_XCNT(b.x)], 1u);
    return b;
}
__device__ __forceinline__ void xcd_barrier_complete(unsigned* bar, unsigned x, unsigned& nloc, unsigned& nx) {
    const unsigned G = gridDim.x * gridDim.y * gridDim.z;
    unsigned sum, cnt, mine, sp = 0u;
    for (;;) {
        sum = 0u; cnt = 0u; mine = 0u;
#pragma unroll
        for (unsigned j = 0; j < 16; ++j) { const unsigned c = xb_ld(&bar[XB_XCNT(j)]); sum += c; cnt += (c > 0u) ? 1u : 0u; mine = (j == x) ? c : mine; }
        if (sum == G) break;
        __builtin_amdgcn_s_sleep(1);
        if ((++sp & 255u) == 0u) { if (xb_ld(&bar[XB_TMO])) break; if (sp > XB_SPIN_CAP) { atomicAdd(&bar[XB_TMO], 1u); break; } }
    }
    nloc = mine > 0u ? mine : 1u; nx = cnt > 0u ? cnt : 1u;
}

__device__ __forceinline__ void xcd_barrier(const XcdBarrier& b, bool t0) {
    asm volatile("s_waitcnt vmcnt(0)" ::: "memory");
    __syncthreads();
    if (t0) {
        unsigned* bar = b.bar;
        __builtin_amdgcn_s_waitcnt(0);
        unsigned nloc = b.st[0], nx = b.st[1];
        if (nloc == 0u) { xcd_barrier_complete(bar, b.x, nloc, nx); b.st[0] = nloc; b.st[1] = nx; }
        const unsigned old = xb_add(&bar[XB_XSUB(b.x)], 1u);
        const unsigned gen = old / nloc;
        if (old + 1u == (gen + 1u) * nloc) {
            __builtin_amdgcn_fence(__ATOMIC_RELEASE, "agent");
            asm volatile("s_waitcnt vmcnt(0)" ::: "memory");
            const unsigned og = xb_add(&bar[XB_TOP], 1u);
            const unsigned tg = og / nx;
            __builtin_amdgcn_fence(__ATOMIC_ACQUIRE, "agent");
            if (og + 1u == (tg + 1u) * nx) xb_add(&bar[XB_TOPGEN], 1u);
            else XB_SPIN(xb_ld(&bar[XB_TOPGEN]) == tg, bar);
            xb_add(&bar[XB_XGEN(b.x)], 1u);
            asm volatile("s_waitcnt vmcnt(0)" ::: "memory");
        } else {
            __builtin_amdgcn_fence(__ATOMIC_ACQUIRE, "agent");
            XB_SPIN(xb_ld(&bar[XB_XGEN(b.x)]) == gen, bar);
            asm volatile("s_waitcnt vmcnt(0)" ::: "memory");
        }
    }
    __syncthreads();
}
constexpr int NWAVES = 8;
#ifndef MK_N_LAUNCHES
#define MK_N_LAUNCHES 1
#endif
constexpr int N_PHASES = 10;
constexpr int N_LAUNCHES = MK_N_LAUNCHES;
static_assert(N_LAUNCHES == 1 || N_LAUNCHES == N_PHASES, "MK_N_LAUNCHES is 1 or N_PHASES");
constexpr int BATCH = 2, SEQ = 4096, DM = 2048, DFF = 5632, NHEAD = 8, HD = 128, DATT = 1024, DSGU = 1024, DIN = 5120, NGRP = 8, CHUNK = 128;
constexpr int M = BATCH * SEQ;
constexpr int N1 = 2 * DFF;
constexpr float EPS = 1e-6f;
constexpr float QSCALE = 0.08838834764831845f * 1.4426950408889634f;
constexpr size_t MiB = 1u << 20;
constexpr size_t WS_CTL = 0, CTL_ZERO_BYTES = 64 * 1024;
constexpr size_t WS_SS1 = 0, WS_SS2 = 256 * 1024, WS_KMEAN = 512 * 1024, WS_SSA = 640 * 1024, WS_SSG = 896 * 1024;
constexpr size_t WS_W1 = 2 * MiB, WS_W2 = 46 * MiB, WS_WIN = 68 * MiB, WS_WOUT = 88 * MiB, WS_W5 = 96 * MiB, WS_W6 = 140 * MiB;
constexpr size_t WS_X1F8 = 178 * MiB;
constexpr size_t WS_XA = 162 * MiB, WS_XB = 194 * MiB;
constexpr size_t WS_ACT = 226 * MiB;
constexpr size_t WS_X2B = 270 * MiB;
constexpr size_t WS_QK = 226 * MiB, WS_V = 290 * MiB, WS_UG = 306 * MiB, WS_MIX = 338 * MiB, WS_END = 370 * MiB;
#ifndef WGM_FF1
#define WGM_FF1 4
#define WGM_RES 2
#define WGM_IN 2
#endif
constexpr int CW_BAR = 4096;
constexpr int G3X_OFF = 137216;
constexpr int RING_BYTES = 131072, LDSCTL_OFF = RING_BYTES, MISC_OFF = LDSCTL_OFF + 320, LDS_BYTES = 147456;

struct Frame {
    LAS unsigned char* lds; volatile LAS unsigned* MISC; gu32* ctl;
    int wave, vcu, G;
};

__device__ __forceinline__ float wave_sum(float v) {
#pragma unroll
    for (int o = 1; o < 64; o <<= 1) v += __shfl_xor(v, o);
    return v;
}
struct P0Mat { const float* W; int K, N; bf16* WT; const float* kg; int mode; int ldk; int f8; int ldn; };
struct P0Job { P0Mat m0, m1, m2, m3; int c0, c1, c2, c3, total; };
__device__ __forceinline__ int p0_cnt(const P0Mat& m) { return (m.K / 64) * (m.N / 32); }
struct P0Item { const float* src; unsigned char* dst; const float* kg; int N, K, f8; };
__device__ __forceinline__ P0Item p0_locate(const P0Job& J, int it, int lane) {
    int r = it; P0Mat mm = J.m0;
    if (r >= J.c0) { r -= J.c0; mm = J.m1; if (r >= J.c1) { r -= J.c1; mm = J.m2; if (r >= J.c2) { r -= J.c2; mm = J.m3; } } }
    const int nblk = mm.N / 32, kb = r / nblk, nb = r - kb * nblk, n0 = 32 * nb, k0 = 64 * kb;
    const int drow0 = mm.mode == 0 ? n0 : 256 * (n0 >> 7) + (n0 & 127) + (mm.mode == 2 ? 128 : 0);
    P0Item I; I.src = mm.W + (size_t)(k0 + (lane >> 5)) * mm.ldn + n0 + (lane & 31); I.f8 = mm.f8; I.dst = (unsigned char*)mm.WT + ((size_t)(drow0 + (lane >> 3)) * mm.ldk + k0 + 8 * (lane & 7)) * (mm.f8 ? 1 : 2);
    I.kg = mm.kg ? mm.kg + k0 + 8 * (lane & 7) : nullptr; I.N = mm.ldn; I.K = mm.ldk * (mm.f8 ? 1 : 2); return I;
}
#define P0_LOAD(w, I) do { _Pragma("unroll") for (int i_ = 0; i_ < 32; ++i_) w[i_] = __builtin_nontemporal_load((I).src + (size_t)(2 * i_) * (I).N); } while (0)
__device__ __forceinline__ void p0_store(const float (&w)[32], const P0Item& I, LAS float* scr, int lane) {
#pragma unroll
    for (int i = 0; i < 32; ++i) scr[(2 * i + (lane >> 5)) * 33 + (lane & 31)] = w[i];
    f32x4 g0 = {1.f, 1.f, 1.f, 1.f}, g1 = g0;
    if (I.kg) { g0 = *(const f32x4*)I.kg; g1 = *(const f32x4*)(I.kg + 4); }
    LDS_WAIT(); asm volatile("" ::: "memory");
    const int c = lane & 7;
#pragma unroll
    for (int j = 0; j < 4; ++j) { const int n = (lane >> 3) + 8 * j; const LAS float* s = scr + (8 * c) * 33 + n;
        if (I.f8) { typedef unsigned u32x2v __attribute__((ext_vector_type(2))); u32x2v o;
            o.x = pg8::cvt_pk4_fp8(s[0 * 33] * g0.x * 256.f, s[1 * 33] * g0.y * 256.f, s[2 * 33] * g0.z * 256.f, s[3 * 33] * g0.w * 256.f);
            o.y = pg8::cvt_pk4_fp8(s[4 * 33] * g1.x * 256.f, s[5 * 33] * g1.y * 256.f, s[6 * 33] * g1.z * 256.f, s[7 * 33] * g1.w * 256.f);
            *(u32x2v*)(I.dst + (size_t)(8 * j) * I.K) = o; }
        else { v4u o; o.x = pk2(s[0 * 33] * g0.x, s[1 * 33] * g0.y); o.y = pk2(s[2 * 33] * g0.z, s[3 * 33] * g0.w); o.z = pk2(s[4 * 33] * g1.x, s[5 * 33] * g1.y); o.w = pk2(s[6 * 33] * g1.z, s[7 * 33] * g1.w);
            *(v4u*)(I.dst + (size_t)(8 * j) * I.K) = o; } }
    LDS_WAIT(); asm volatile("" ::: "memory");
}
__device__ __forceinline__ void p0_run(const P0Job& J, int w, int nw, LAS float* scr, int lane) {
    float w0[32], w1[32], w2[32], w3[32], w4[32];
    P0Item I0, I1, I2, I3, I4;
    const int T = J.total; int it = w; if (it >= T) return;
#define P0_ISSUE(wx, Ix, idx) do { if ((idx) < T) { Ix = p0_locate(J, (idx), lane); P0_LOAD(wx, Ix); } } while (0)
    I0 = p0_locate(J, it, lane); I1 = I0; I2 = I0; I3 = I0; I4 = I0;
    P0_LOAD(w0, I0); P0_ISSUE(w1, I1, it + nw); P0_ISSUE(w2, I2, it + 2 * nw); P0_ISSUE(w3, I3, it + 3 * nw);
    for (;;) {
        P0_ISSUE(w4, I4, it + 4 * nw); p0_store(w0, I0, scr, lane); if (it + nw >= T) break;
        P0_ISSUE(w0, I0, it + 5 * nw); p0_store(w1, I1, scr, lane); if (it + 2 * nw >= T) break;
        P0_ISSUE(w1, I1, it + 6 * nw); p0_store(w2, I2, scr, lane); if (it + 3 * nw >= T) break;
        P0_ISSUE(w2, I2, it + 7 * nw); p0_store(w3, I3, scr, lane); if (it + 4 * nw >= T) break;
        P0_ISSUE(w3, I3, it + 8 * nw); p0_store(w4, I4, scr, lane); if (it + 5 * nw >= T) break;
        it += 5 * nw;
    }
#undef P0_ISSUE
}
__device__ __forceinline__ void rms_rows_to_fp8(const float* x, const float* g, unsigned char* o, int first, int step, int lane) {
    const f32x4* gr = (const f32x4*)g + lane;
    f32x4 va[8], vb[8];
#define RR_LOAD(v, m_) do { const f32x4* xr_ = (const f32x4*)(x + (size_t)(m_) * DM) + lane; _Pragma("unroll") for (int j_ = 0; j_ < 8; ++j_) v[j_] = __builtin_nontemporal_load(xr_ + 64 * j_); } while (0)
#define RR_DO(v, m_) do { float s_ = 0.f; _Pragma("unroll") for (int j_ = 0; j_ < 8; ++j_) s_ += (v[j_].x * v[j_].x + v[j_].y * v[j_].y) + (v[j_].z * v[j_].z + v[j_].w * v[j_].w); \
        const float rs_ = 1.0f / sqrtf(wave_sum(s_) * (1.f / DM) + EPS); unsigned* o4_ = (unsigned*)(o + (size_t)(m_) * DM) + lane; \
        _Pragma("unroll") for (int j_ = 0; j_ < 8; ++j_) { const f32x4 gg_ = gr[64 * j_]; o4_[64 * j_] = pg8::cvt_pk4_fp8(v[j_].x * rs_ * gg_.x, v[j_].y * rs_ * gg_.y, v[j_].z * rs_ * gg_.z, v[j_].w * rs_ * gg_.w); } } while (0)
    int m = first; if (m >= M) return;
    RR_LOAD(va, m);
    for (;;) {
        const int m1 = m + step; if (m1 < M) RR_LOAD(vb, m1);
        RR_DO(va, m); if (m1 >= M) break;
        const int m2 = m1 + step; if (m2 < M) RR_LOAD(va, m2);
        RR_DO(vb, m1); if (m2 >= M) break;
        m = m2;
    }
#undef RR_LOAD
#undef RR_DO
}

constexpr int SG_STRIDE = 272;
__device__ __forceinline__ void sgu_item(Frame& F, const bf16* UG, const float* ln_g, const float* ln_b, const float* w_s, const float* b_s, bf16* MIX, float* ssg, int item) {
    const int g = item & 7, chunk = item >> 3;
    LAS unsigned char* GT = F.lds; LAS unsigned char* WL = F.lds + 128 * SG_STRIDE;
    const size_t row0 = (size_t)chunk * CHUNK;
    {
        const int s = (F.wave * 64 + mk_lane()) >> 2, cq = ((F.wave * 64 + mk_lane()) & 3) * 32;
        const bf16* gp = UG + (row0 + s) * 2048 + 1024 + g * 128 + cq;
        float x[32];
#pragma unroll
        for (int j = 0; j < 4; ++j) { const v4u w = *(const v4u*)(gp + 8 * j);
#pragma unroll
            for (int e = 0; e < 4; ++e) { x[8 * j + 2 * e] = __uint_as_float(w[e] << 16); x[8 * j + 2 * e + 1] = __uint_as_float(w[e] & 0xffff0000u); } }
        float sm = 0.f;
#pragma unroll
        for (int j = 0; j < 32; ++j) sm += x[j];
        sm += __shfl_xor(sm, 1); sm += __shfl_xor(sm, 2);
        const float mu = sm * (1.f / 128.f); float q = 0.f;
#pragma unroll
        for (int j = 0; j < 32; ++j) { x[j] -= mu; q += x[j] * x[j]; }
        q += __shfl_xor(q, 1); q += __shfl_xor(q, 2);
        const float rs = 1.0f / sqrtf(q * (1.f / 128.f) + EPS);
#pragma unroll
        for (int j = 0; j < 32; ++j) { const float y = x[j] * rs * ln_g[g * 128 + cq + j] + ln_b[g * 128 + cq + j];
            *(LAS unsigned short*)(GT + (cq + j) * SG_STRIDE + 2 * s) = (unsigned short)f2bf(y); }
    }
    {
        const int t = (F.wave * 64 + mk_lane()) >> 2, sq = ((F.wave * 64 + mk_lane()) & 3) * 32;
        const float* wp = w_s + ((size_t)g * 128 + t) * 128 + sq;
#pragma unroll
        for (int j = 0; j < 4; ++j) { const f32x4 a = *(const f32x4*)(wp + 8 * j), c = *(const f32x4*)(wp + 8 * j + 4); const int s0 = sq + 8 * j;
            v4u o; o.x = pk2(s0 + 0 <= t ? a.x : 0.f, s0 + 1 <= t ? a.y : 0.f); o.y = pk2(s0 + 2 <= t ? a.z : 0.f, s0 + 3 <= t ? a.w : 0.f);
            o.z = pk2(s0 + 4 <= t ? c.x : 0.f, s0 + 5 <= t ? c.y : 0.f); o.w = pk2(s0 + 6 <= t ? c.z : 0.f, s0 + 7 <= t ? c.w : 0.f);
            *(LAS v4u*)(WL + t * SG_STRIDE + 2 * s0) = o; }
    }
    LDS_WAIT(); __syncthreads();
    {
        const int fr = mk_lane() & 15, fq = mk_lane() >> 4, w = F.wave;
        f32x4 acc[8];
#pragma unroll
        for (int n = 0; n < 8; ++n) acc[n] = (f32x4){0.f, 0.f, 0.f, 0.f};
        const int ksn = (16 * w + 15) / 32 + 1;
        for (int ks = 0; ks < ksn; ++ks) {
            const bf16x8 bfr = *(const LAS bf16x8*)(WL + (16 * w + fr) * SG_STRIDE + 2 * (32 * ks + 8 * fq));
#pragma unroll
            for (int n = 0; n < 8; ++n) { const bf16x8 afr = *(const LAS bf16x8*)(GT + (16 * n + fr) * SG_STRIDE + 2 * (32 * ks + 8 * fq));
                acc[n] = __builtin_amdgcn_mfma_f32_16x16x32_bf16(afr, bfr, acc[n], 0, 0, 0); }
        }
        const int t = 16 * w + fr; const float bias = b_s[g * 128 + t];
        const bf16* up = UG + (row0 + t) * 2048 + g * 128 + 4 * fq; unsigned char* op = (unsigned char*)MIX + (row0 + t) * 2048 + 1024 + g * 128 + 4 * fq; float qs = 0.f;
#pragma unroll
        for (int n = 0; n < 8; ++n) { const unsigned long long uw = *(const unsigned long long*)(up + 16 * n); const unsigned u0 = (unsigned)uw, u1 = (unsigned)(uw >> 32);
            const float o0 = __uint_as_float(u0 << 16) * (acc[n][0] + bias), o1 = __uint_as_float(u0 & 0xffff0000u) * (acc[n][1] + bias);
            const float o2 = __uint_as_float(u1 << 16) * (acc[n][2] + bias), o3 = __uint_as_float(u1 & 0xffff0000u) * (acc[n][3] + bias);
            const unsigned w0 = pg8::cvt_pk4_fp8(o0, o1, o2, o3);
            *(unsigned*)(op + 16 * n) = w0;
            const float y0 = __builtin_amdgcn_cvt_f32_fp8((int)w0, 0), y1 = __builtin_amdgcn_cvt_f32_fp8((int)w0, 1), y2 = __builtin_amdgcn_cvt_f32_fp8((int)w0, 2), y3 = __builtin_amdgcn_cvt_f32_fp8((int)w0, 3);
            qs += (y0 * y0 + y1 * y1) + (y2 * y2 + y3 * y3); }
        qs += __shfl_xor(qs, 16); qs += __shfl_xor(qs, 32);
        if (fq == 0) ssg[(row0 + t) * 8 + g] = qs;
    }
    __syncthreads();
}

__device__ __forceinline__ void norm2_row(bf16* row, int lane) {
    v4u* p = (v4u*)row + lane;
#pragma unroll
    for (int hsel = 0; hsel < 2; ++hsel) {
        v4u w[2]; float x[16]; float s = 0.f;
#pragma unroll
        for (int j = 0; j < 2; ++j) { w[j] = p[hsel * 128 + 64 * j];
#pragma unroll
            for (int e = 0; e < 4; ++e) { x[8 * j + 2 * e] = __uint_as_float(w[j][e] << 16); x[8 * j + 2 * e + 1] = __uint_as_float(w[j][e] & 0xffff0000u); } }
#pragma unroll
        for (int j = 0; j < 16; ++j) s += x[j] * x[j];
        const float rs = 1.0f / sqrtf(wave_sum(s) * (1.f / 1024.f) + EPS);
#pragma unroll
        for (int j = 0; j < 2; ++j) { v4u o;
#pragma unroll
            for (int e = 0; e < 4; ++e) o[e] = pk2(x[8 * j + 2 * e] * rs, x[8 * j + 2 * e + 1] * rs);
            p[hsel * 128 + 64 * j] = o; }
    }
}
constexpr int BAR_DONE = XCD_BAR_WORDS;
__device__ unsigned g_bar[XCD_BAR_WORDS + 64];
struct Args { const float* in[20]; float* out; unsigned char* ws; int ph_lo, ph_hi; };
__global__ void __launch_bounds__(NWAVES * 64, 2) hymba_fwd(Args args) {
    extern __shared__ __attribute__((aligned(16))) unsigned char lds[];
    Frame F;
    F.lds = (LAS unsigned char*)lds;
    F.MISC = (volatile LAS unsigned*)(F.lds + MISC_OFF);
    F.wave = __builtin_amdgcn_readfirstlane((int)threadIdx.x >> 6);
    F.G = gridDim.x; { const int bx = blockIdx.x; F.vcu = (F.G % 8 == 0) ? (bx % 8) * (F.G / 8) + bx / 8 : bx; }
    unsigned char* ws = args.ws;
    F.ctl = (gu32*)(ws + WS_CTL);
    const float* x = args.in[0];
    float* out = args.out;
    bf16* W1t = (bf16*)(ws + WS_W1); bf16* W2t = (bf16*)(ws + WS_W2); bf16* Wint = (bf16*)(ws + WS_WIN); bf16* Wvug = (bf16*)(ws + WS_WIN + 8 * MiB);   bf16* Woutt = (bf16*)(ws + WS_WOUT); bf16* W5t = (bf16*)(ws + WS_W5); bf16* W6t = (bf16*)(ws + WS_W6);
    bf16* XA = (bf16*)(ws + WS_XA); bf16* XB = (bf16*)(ws + WS_XB); bf16* ACT = (bf16*)(ws + WS_ACT);
    bf16* X2B = (bf16*)(ws + WS_X2B); unsigned char* X1F8 = ws + WS_X1F8;
    bf16* QK = (bf16*)(ws + WS_QK); bf16* VB = (bf16*)(ws + WS_V); bf16* UG = (bf16*)(ws + WS_UG); bf16* MIX = (bf16*)(ws + WS_MIX);
    float* SS1 = (float*)(ws + WS_SS1); float* SS2 = (float*)(ws + WS_SS2); float* KMEAN = (float*)(ws + WS_KMEAN); float* SSA = (float*)(ws + WS_SSA); float* SSG = (float*)(ws + WS_SSG);
    for (int u = (F.wave * 64 + mk_lane()); u < (LDS_BYTES - LDSCTL_OFF) / 4; u += NWAVES * 64) ((LAS unsigned*)(F.lds + LDSCTL_OFF))[u] = 0u;
    __syncthreads();
    XcdBarrier bar; bar.bar = g_bar; bar.x = 0; bar.st = nullptr;
    if (N_LAUNCHES == 1) bar = xcd_barrier_post(g_bar, F.MISC + 8, F.wave == 0 && mk_lane() == 0);
    const int lo = args.ph_lo, hi = args.ph_hi;
#define IN(k) (lo <= (k) && (k) < hi)
#define SEAM(k) do { if (IN(k) && IN((k) + 1)) xcd_barrier(bar, F.wave == 0 && mk_lane() == 0); } while (0)
    const int gw = F.vcu * NWAVES + F.wave, NGW = F.G * NWAVES;

    LAS float* scr = (LAS float*)(F.lds + F.wave * 16384);
    if (IN(0)) {
        rms_rows_to_fp8(x, args.in[1], (unsigned char*)XA, gw, NGW, mk_lane());
        P0Job J; J.m0 = P0Mat{args.in[2], DM, DFF, W1t, nullptr, 1, DM, 1, DFF}; J.m1 = P0Mat{args.in[3], DM, DFF, W1t, nullptr, 2, DM, 1, DFF}; J.m2 = J.m0; J.m3 = J.m0;
        J.c0 = p0_cnt(J.m0); J.c1 = p0_cnt(J.m1); J.c2 = 0; J.c3 = 0; J.total = J.c0 + J.c1;
        p0_run(J, gw, NGW, scr, mk_lane());
    }
    SEAM(0);
    if (IN(1)) {
        pg8::Gemm g{XA, W1t, M, N1, DM / 2}; pg8::StaticOrder S; S.init(M, N1, F.G, (int)blockIdx.x, WGM_FF1);
        pg8::EpiSwiGLU<true> E{ACT, DFF, nullptr, 1.0f / 256.0f};
        pg8::gemm_phase<pg8::EpiSwiGLU<true>, pg8::StaticOrder, true, true, true>(F.lds, g, S, E, F.wave);
        const int nrem = ((M / 256) * (N1 / 256)) % F.G, nidle = nrem ? F.G - nrem : F.G;
        if (!nrem || (int)blockIdx.x >= nrem) {
            P0Job J; J.m0 = P0Mat{args.in[4], DFF, DM, W2t, nullptr, 0, DFF, 1, DM}; J.m1 = P0Mat{args.in[6], DM, 2048, Wint, args.in[5], 0, DM, 0, DIN};
            J.m2 = P0Mat{args.in[6] + 2048, DM, 3072, Wvug, args.in[5], 0, DM, 1, DIN}; J.m3 = P0Mat{args.in[15], DATT, DM, Woutt, args.in[13], 0, DM, 1, DM};
            J.c0 = p0_cnt(J.m0); J.c1 = p0_cnt(J.m1); J.c2 = p0_cnt(J.m2); J.c3 = p0_cnt(J.m3); J.total = J.c0 + J.c1 + J.c2 + J.c3;
            p0_run(J, (nrem ? (int)blockIdx.x - nrem : (int)blockIdx.x) * NWAVES + F.wave, nidle * NWAVES, scr, mk_lane());
        }
    }
    SEAM(1);
    if (IN(2)) {
        pg8::Gemm g{ACT, W2t, M, DM, DFF / 2}; pg8::StaticOrder S; S.init(M, DM, F.G, (int)blockIdx.x, WGM_RES);
        pg8::EpiResid<false> E{x, nullptr, XB, X1F8, SS1, 0.5f / 256.0f, nullptr};
        pg8::gemm_phase<pg8::EpiResid<false>, pg8::StaticOrder, false, true, true>(F.lds, g, S, E, F.wave);
    }
    SEAM(2);
    if (IN(3)) {
        { pg8::Gemm g{XB, Wint, M, 2048, DM}; pg8::StaticOrder S; S.init(M, 2048, F.G, (int)blockIdx.x, WGM_RES);
          pg8::EpiG3 E{QK, VB, UG, SS1, args.in[7], args.in[8], KMEAN, F.lds + G3X_OFF, QSCALE, 0, 1.0f};
          pg8::gemm_phase<pg8::EpiG3, pg8::StaticOrder, true, true>(F.lds, g, S, E, F.wave); }
        { pg8::Gemm g{(const bf16*)X1F8, Wvug, M, 3072, DM / 2}; pg8::StaticOrder S; S.init(M, 3072, F.G, (int)blockIdx.x, WGM_IN);
          pg8::EpiVUG E{VB, UG, SS1, 1.0f / 256.0f};
          pg8::gemm_phase<pg8::EpiVUG, pg8::StaticOrder, true, true, true>(F.lds, g, S, E, F.wave); }
        const int nrem = ((M / 256) * (3072 / 256)) % F.G, nidle = nrem ? F.G - nrem : F.G;
        if (!nrem || (int)blockIdx.x >= nrem) {
            P0Job J; J.m0 = P0Mat{args.in[17], DM, DFF, W5t, args.in[16], 1, DM, 1, DFF}; J.m1 = P0Mat{args.in[18], DM, DFF, W5t, args.in[16], 2, DM, 1, DFF};
            J.m2 = P0Mat{args.in[15] + (size_t)DATT * DM, DSGU, DM, (bf16*)((unsigned char*)Woutt + DATT), args.in[14], 0, DM, 1, DM}; J.m3 = J.m0;
            J.c0 = p0_cnt(J.m0); J.c1 = p0_cnt(J.m1); J.c2 = p0_cnt(J.m2); J.c3 = 0; J.total = J.c0 + J.c1 + J.c2;
            p0_run(J, (nrem ? (int)blockIdx.x - nrem : (int)blockIdx.x) * NWAVES + F.wave, nidle * NWAVES, scr, mk_lane());
        }
    }
    SEAM(3);
    if (IN(5)) {
        for (int pr = F.vcu; pr < 256; pr += F.G) {
            const int bh0 = (pr >> 5) * 2, c = pr & 31, j = c >> 1, qbA = j >> 1, half = j & 1, role = c & 1;
            att::attn_unit(bh0 >> 3, bh0 & 7, role ? qbA : 15 - qbA, half, (const unsigned char*)QK, VB, KMEAN, MIX, SSA, F.lds, F.wave);
            att::attn_unit((bh0 + 1) >> 3, (bh0 + 1) & 7, role ? 15 - qbA : qbA, half, (const unsigned char*)QK, VB, KMEAN, MIX, SSA, F.lds, F.wave); }
        for (int it = F.vcu; it < 512; it += F.G) sgu_item(F, UG, args.in[9], args.in[10], args.in[11], args.in[12], MIX, SSG, it);
    }
    SEAM(5);
    if (IN(7)) {
        pg8::Gemm g{MIX, Woutt, M, DM, DM / 2}; pg8::StaticOrder S; S.init(M, DM, F.G, (int)blockIdx.x, WGM_RES);
        { pg8::Unit u0; if (S.next(0, u0)) { const int t = F.wave * 64 + mk_lane();
              if (t < 256) { const size_t row = (size_t)u0.pm * 256 + t; const f32x4 a0 = *(const f32x4*)(SSA + row * 8), a1 = *(const f32x4*)(SSA + row * 8 + 4), g0 = *(const f32x4*)(SSG + row * 8), g1 = *(const f32x4*)(SSG + row * 8 + 4);
                  const float sa = ((a0[0] + a0[1]) + (a0[2] + a0[3])) + ((a1[0] + a1[1]) + (a1[2] + a1[3])), sg = ((g0[0] + g0[1]) + (g0[2] + g0[3])) + ((g1[0] + g1[1]) + (g1[2] + g1[3]));
                  const float ra = 1.0f / sqrtf(sa * (1.0f / 1024.0f) + 256.0f * EPS), rs = 1.0f / sqrtf(sg * (1.0f / 1024.0f) + EPS);
                  LAS float* T = (LAS float*)(F.lds + G3X_OFF); T[2 * t] = ra / rs; T[2 * t + 1] = rs; } }
          LDS_WAIT(); __syncthreads(); }
        pg8::EpiResid<true, true> E{XB, nullptr, X2B, (unsigned char*)XA, SS2, 1.0f / 256.0f, (const LAS float*)(F.lds + G3X_OFF)};
        pg8::gemm_phase<pg8::EpiResid<true, true>, pg8::StaticOrder, false, true, true>(F.lds, g, S, E, F.wave);
    }
    SEAM(7);
    if (IN(8)) {
        pg8::Gemm g{XA, W5t, M, N1, DM / 2}; pg8::StaticOrder S; S.init(M, N1, F.G, (int)blockIdx.x, WGM_FF1);
        pg8::EpiSwiGLU<true> E{ACT, DFF, SS2, 1.0f / 256.0f};
        pg8::gemm_phase<pg8::EpiSwiGLU<true>, pg8::StaticOrder, true, true, true>(F.lds, g, S, E, F.wave);
        const int nrem = ((M / 256) * (N1 / 256)) % F.G, nidle = nrem ? F.G - nrem : F.G;
        if (!nrem || (int)blockIdx.x >= nrem) {
            P0Job J; J.m0 = P0Mat{args.in[19], DFF, DM, W6t, nullptr, 0, DFF, 1, DM}; J.m1 = J.m0; J.m2 = J.m0; J.m3 = J.m0;
            J.c0 = p0_cnt(J.m0); J.c1 = 0; J.c2 = 0; J.c3 = 0; J.total = J.c0;
            p0_run(J, (nrem ? (int)blockIdx.x - nrem : (int)blockIdx.x) * NWAVES + F.wave, nidle * NWAVES, scr, mk_lane());
        }
    }
    SEAM(8);
    if (IN(9)) {
        pg8::Gemm g{ACT, W6t, M, DM, DFF / 2}; pg8::StaticOrder S; S.init(M, DM, F.G, (int)blockIdx.x, WGM_RES);
        pg8::EpiResid<true> E{X2B, out, nullptr, nullptr, nullptr, 0.5f / 256.0f, nullptr};
        pg8::gemm_phase<pg8::EpiResid<true>, pg8::StaticOrder, false, true, true>(F.lds, g, S, E, F.wave);
    }
    if (F.wave == 0 && mk_lane() == 0) F.MISC[12] = (xb_add(&g_bar[BAR_DONE], 1u) == (unsigned)gridDim.x - 1u) ? 1u : 0u;
    __syncthreads();
    if (F.MISC[12]) { for (int i = F.wave * 64 + mk_lane(); i < XCD_BAR_WORDS + 64; i += NWAVES * 64) __hip_atomic_store(&g_bar[i], 0u, __ATOMIC_RELAXED, __HIP_MEMORY_SCOPE_AGENT); }
#undef IN
#undef SEAM
}

extern "C" void kernel_launch(void* const* d_in, const int* in_sizes, int n_in, void* d_out, int out_size, void* d_ws, size_t ws_size, hipStream_t stream) {
    static int grid = 0;
    if (grid == 0) {
        if (n_in != 20 || in_sizes[0] != M * DM || out_size != M * DM || ws_size < WS_END) { fprintf(stderr, "kernel_launch: shape/workspace mismatch (n_in %d, in0 %d, out %d, ws %zu, need %zu); nothing launched\n", n_in, n_in > 0 ? in_sizes[0] : -1, out_size, ws_size, (size_t)WS_END); grid = -1; return; }
        int dev = 0, cus = 0, per_cu = 0;
        if (hipGetDevice(&dev) != hipSuccess || hipDeviceGetAttribute(&cus, hipDeviceAttributeMultiprocessorCount, dev) != hipSuccess) { grid = -1; return; }
        if (hipFuncSetAttribute((const void*)hymba_fwd, hipFuncAttributeMaxDynamicSharedMemorySize, LDS_BYTES) != hipSuccess) { fprintf(stderr, "kernel_launch: hipFuncSetAttribute failed\n"); grid = -1; return; }
        if (hipOccupancyMaxActiveBlocksPerMultiprocessor(&per_cu, (const void*)hymba_fwd, NWAVES * 64, LDS_BYTES) != hipSuccess || per_cu < 1) { fprintf(stderr, "kernel_launch: occupancy query says %d blocks per CU\n", per_cu); }
        (void)hipGetLastError();
        grid = cus;
        if (grid != 256) fprintf(stderr, "kernel_launch: %d CUs; the residual GEMM phases assume 256 workgroups\n", grid);
    }
    if (grid < 0) return;
    Args a{};
    for (int i = 0; i < 20; ++i) a.in[i] = (const float*)d_in[i];
    a.out = (float*)d_out; a.ws = (unsigned char*)d_ws;
    for (int li = 0; li < N_LAUNCHES; ++li) {
        a.ph_lo = (N_LAUNCHES == 1) ? 0 : li; a.ph_hi = (N_LAUNCHES == 1) ? N_PHASES : li + 1;
        hipLaunchKernelGGL(hymba_fwd, dim3(grid), dim3(NWAVES * 64), LDS_BYTES, stream, a);
    }
}
```

```cpp
#include <hip/hip_runtime.h>
#include <cstdio>
#include <cstdint>
__device__ __forceinline__ int mk_lane() { int l; asm volatile("v_mbcnt_lo_u32_b32 %0, -1, 0\n\tv_mbcnt_hi_u32_b32 %0, -1, %0" : "=v"(l)); return l; }
namespace pg8 {
#define PG8_LAS __attribute__((address_space(3)))
typedef unsigned short bf16_t;
typedef short bf16x8 __attribute__((ext_vector_type(8)));
typedef float f32x4 __attribute__((ext_vector_type(4)));
typedef unsigned u32x4 __attribute__((ext_vector_type(4)));
typedef int i32x4 __attribute__((ext_vector_type(4)));
constexpr int BM = 256, BK = 64, HALF = 128, HTB = HALF * BK * 2  , STAGE_BYTES = 8 * HTB, NXCD = 8, WGM = 8;

__host__ __device__ __forceinline__ int lds_byte(int r, int c) { const int st = (r >> 4) * 2 + (c >> 5), rr = r & 15, cc = c & 31, ob = rr * 64 + cc * 2; return st * 1024 + (ob ^ (((ob >> 9) & 1) << 5)); }
__host__ __device__ __forceinline__ void stage_rc(int b, int& R, int& C) { const int st = b / 1024, sb = b % 1024, swz = sb ^ (((sb >> 9) & 1) << 5); R = (st >> 1) * 16 + swz / 64; C = (st & 1) * 32 + (swz % 64) / 2; }
__host__ __device__ __forceinline__ int perm32(int rho) { const int n = rho >> 4, i = rho & 15; return 8 * (i >> 2) + 4 * n + (i & 3); }

struct Unit { int pm, pn; };
struct Gemm { const bf16_t* A; const bf16_t* Bt; int M, N, K; };

struct StaticOrder {
    int nM, nN, nwg, G, c, wgm, i0, i1;
    __host__ __device__ __forceinline__ void init(int M, int N, int G_, int c_, int wgm_ = WGM) { nM = M / BM; nN = N / BM; nwg = nM * nN; G = G_; c = c_; wgm = wgm_; i0 = 0; i1 = 1 << 20; }
    __host__ __device__ __forceinline__ bool next(int i, Unit& u) const {
        if (i + i0 >= i1) return false;
        const long L = (long)(i + i0) * G + c; if (L >= nwg) return false;
        int wgid = (int)L; { const int q = nwg / NXCD, r = nwg % NXCD, xcd = wgid % NXCD, off = wgid / NXCD; wgid = (xcd < r ? xcd * (q + 1) : r * (q + 1) + (xcd - r) * q) + off; }
        const int nig = wgm * nN, gid = wgid / nig, fm = gid * wgm, gsz = (nM - fm) < wgm ? (nM - fm) : wgm;
        u.pm = fm + ((wgid % nig) % gsz); u.pn = (wgid % nig) / gsz; return true;
    }
    __device__ __forceinline__ void a_ready(const Unit&) const {}
    __device__ __forceinline__ void done(const Unit&) const {}
};

__device__ __forceinline__ unsigned cvt_pk_bf16(float lo, float hi) { unsigned r; asm volatile("v_cvt_pk_bf16_f32 %0, %1, %2" : "=v"(r) : "v"(lo), "v"(hi)); return r; }
constexpr int DMODEL = 2048;
__device__ __forceinline__ unsigned cvt_pk4_fp8(float a, float b, float c, float d) {
    a = __builtin_amdgcn_fmed3f(a, -448.f, 448.f); b = __builtin_amdgcn_fmed3f(b, -448.f, 448.f); c = __builtin_amdgcn_fmed3f(c, -448.f, 448.f); d = __builtin_amdgcn_fmed3f(d, -448.f, 448.f);
    unsigned w = 0u; w = __builtin_amdgcn_cvt_pk_fp8_f32(a, b, w, false); w = __builtin_amdgcn_cvt_pk_fp8_f32(c, d, w, true); return w;
}
__device__ __forceinline__ float row_rs(const float* ss, int row) {
    const f32x4 a = *(const f32x4*)(ss + (size_t)row * 8), b = *(const f32x4*)(ss + (size_t)row * 8 + 4);
    const float s = ((a[0] + a[1]) + (a[2] + a[3])) + ((b[0] + b[1]) + (b[2] + b[3]));
    return 1.0f / sqrtf(s * (1.0f / DMODEL) + 1e-6f);
}
struct RowScales { float loc[2];
    __device__ __forceinline__ void load(const float* ss, int row0, int fq, float post) {
#pragma unroll
        for (int ai = 0; ai < 2; ++ai) loc[ai] = (ss ? row_rs(ss, row0 + ai * HALF + fq * 16) : 1.0f) * post; }
    __device__ __forceinline__ float get(int ai, int m, int fr) const { return __shfl(loc[ai], fr + 16 * m); }
};
__device__ __forceinline__ float silu_f(float g) { return g * __builtin_amdgcn_rcpf(1.0f + __builtin_amdgcn_exp2f(-1.4426950408889634f * g)); }
__device__ __forceinline__ float gelu_f(float z) { const float t = z * (1.0f + 0.044715f * z * z); return z * __builtin_amdgcn_rcpf(1.0f + __builtin_amdgcn_exp2f(-2.302208198f * t)); }

template <bool OUT8> struct EpiSwiGLU {
    static constexpr bool PERM = true, AFTER_DRAIN = false, MIDK = false;
    bf16_t* O; int ldc; const float* ss; float post;
    __device__ __forceinline__ void operator()(const f32x4 (&acc)[2][2][4][2], const Unit& u, int wr, int wc, int fr, int fq) const {
        const int row0 = u.pm * BM + wr * 64 + fr, col0 = u.pn * HALF + wc * 32 + 8 * fq;
        RowScales rsc; rsc.load(ss, row0, fq, post);
#pragma unroll
        for (int ai = 0; ai < 2; ++ai)
#pragma unroll
            for (int m = 0; m < 4; ++m) { const int row = row0 + ai * HALF + m * 16; const float r = rsc.get(ai, m, fr), c1 = -1.4426950408889634f * r, r2 = r * r;
                typedef float f2 __attribute__((ext_vector_type(2)));
                f2 g[4], uu[4], t[4]; float a[8];
#pragma unroll
                for (int k = 0; k < 4; ++k) { g[k] = (f2){acc[ai][0][m][k >> 1][2 * (k & 1)], acc[ai][0][m][k >> 1][2 * (k & 1) + 1]}; uu[k] = (f2){acc[ai][1][m][k >> 1][2 * (k & 1)], acc[ai][1][m][k >> 1][2 * (k & 1) + 1]}; }
#pragma unroll
                for (int k = 0; k < 4; ++k) t[k] = g[k] * c1;
#pragma unroll
                for (int k = 0; k < 4; ++k) { t[k].x = __builtin_amdgcn_exp2f(t[k].x); t[k].y = __builtin_amdgcn_exp2f(t[k].y); }
#pragma unroll
                for (int k = 0; k < 4; ++k) t[k] = t[k] + 1.0f;
#pragma unroll
                for (int k = 0; k < 4; ++k) { t[k].x = __builtin_amdgcn_rcpf(t[k].x); t[k].y = __builtin_amdgcn_rcpf(t[k].y); }
#pragma unroll
                for (int k = 0; k < 4; ++k) { const f2 w = (g[k] * uu[k]) * (t[k] * r2); a[2 * k] = w.x; a[2 * k + 1] = w.y; }
                if constexpr (OUT8) { typedef unsigned u32x2v __attribute__((ext_vector_type(2))); u32x2v w; w.x = cvt_pk4_fp8(a[0], a[1], a[2], a[3]); w.y = cvt_pk4_fp8(a[4], a[5], a[6], a[7]);
                    *(u32x2v*)((unsigned char*)O + (size_t)row * ldc + col0) = w; }
                else { u32x4 w; w.x = cvt_pk_bf16(a[0], a[1]); w.y = cvt_pk_bf16(a[2], a[3]); w.z = cvt_pk_bf16(a[4], a[5]); w.w = cvt_pk_bf16(a[6], a[7]);
                    *(u32x4*)(O + (size_t)row * ldc + col0) = w; } }
    }
};
struct EpiG3 {
    static constexpr bool PERM = true, AFTER_DRAIN = false, MIDK = false;
    bf16_t* QKn; bf16_t* V; bf16_t* UG; const float* ss; const float* qg; const float* kg; float* kmean; PG8_LAS unsigned char* xl; float qscale; int pn0; float post;
    __device__ __forceinline__ void operator()(f32x4 (&acc)[2][2][4][2], const Unit& u, int wr, int wc, int fr, int fq) const {
        const int row0 = u.pm * BM + wr * 64 + fr, cw = wc * 32 + 8 * fq, pn = u.pn + pn0;
        RowScales rsc; rsc.load(ss, row0, fq, post);
        if (pn < 8) {
            PG8_LAS float* PS = (PG8_LAS float*)xl;
            PG8_LAS float* KS = (PG8_LAS float*)(xl + 8192);
#pragma unroll
            for (int ai = 0; ai < 2; ++ai)
#pragma unroll
                for (int m = 0; m < 4; ++m) { const float r = rsc.get(ai, m, fr); const int rl = ai * HALF + wr * 64 + m * 16 + fr;
#pragma unroll
                    for (int bj = 0; bj < 2; ++bj) { f32x4 v0 = acc[ai][bj][m][0] * r, v1 = acc[ai][bj][m][1] * r; acc[ai][bj][m][0] = v0; acc[ai][bj][m][1] = v1;
                        float q = ((v0[0] * v0[0] + v0[1] * v0[1]) + (v0[2] * v0[2] + v0[3] * v0[3])) + ((v1[0] * v1[0] + v1[1] * v1[1]) + (v1[2] * v1[2] + v1[3] * v1[3]));
                        q += __shfl_xor(q, 16); q += __shfl_xor(q, 32);
                        if (fq == 0) PS[(rl * 2 + bj) * 4 + wc] = q; } }
            asm volatile("s_waitcnt lgkmcnt(0)" ::: "memory"); __builtin_amdgcn_s_barrier(); asm volatile("" ::: "memory");
            const bool isk = pn >= 4; const float* gp = (isk ? kg : qg) + cw; const f32x4 g0 = *(const f32x4*)gp, g1 = *(const f32x4*)(gp + 4);
            const float post = isk ? 1.0f : qscale;
            f32x4 cs[2][2] = {{{0.f, 0.f, 0.f, 0.f}, {0.f, 0.f, 0.f, 0.f}}, {{0.f, 0.f, 0.f, 0.f}, {0.f, 0.f, 0.f, 0.f}}};
#pragma unroll
            for (int ai = 0; ai < 2; ++ai)
#pragma unroll
                for (int m = 0; m < 4; ++m) { const int rl = ai * HALF + wr * 64 + m * 16 + fr;
#pragma unroll
                    for (int bj = 0; bj < 2; ++bj) { const f32x4 ps = *(const PG8_LAS f32x4*)(PS + (rl * 2 + bj) * 4);
                        const float rs = post / sqrtf(((ps[0] + ps[1]) + (ps[2] + ps[3])) * (1.0f / 128.0f) + 1e-6f);
                        const f32x4 y0 = acc[ai][bj][m][0] * rs * g0, y1 = acc[ai][bj][m][1] * rs * g1;
                        cs[bj][0] += y0; cs[bj][1] += y1;
                        u32x4 w; w.x = cvt_pk_bf16(y0[0], y0[1]); w.y = cvt_pk_bf16(y0[2], y0[3]); w.z = cvt_pk_bf16(y1[0], y1[1]); w.w = cvt_pk_bf16(y1[2], y1[3]);
                        *(u32x4*)(QKn + (size_t)(u.pm * BM + rl) * 2048 + pn * BM + bj * HALF + cw) = w; } }
            if (isk) {
#pragma unroll
                for (int bj = 0; bj < 2; ++bj)
#pragma unroll
                    for (int n = 0; n < 2; ++n)
#pragma unroll
                        for (int j = 0; j < 4; ++j) { float s = cs[bj][n][j]; s += __shfl_xor(s, 1); s += __shfl_xor(s, 2); s += __shfl_xor(s, 4); s += __shfl_xor(s, 8); cs[bj][n][j] = s; }
                if (fr == 0) {
#pragma unroll
                    for (int bj = 0; bj < 2; ++bj) { *(PG8_LAS f32x4*)(KS + wr * 256 + bj * HALF + cw) = cs[bj][0]; *(PG8_LAS f32x4*)(KS + wr * 256 + bj * HALF + cw + 4) = cs[bj][1]; } }
                asm volatile("s_waitcnt lgkmcnt(0)" ::: "memory"); __builtin_amdgcn_s_barrier(); asm volatile("" ::: "memory");
                const int t = (wr * 4 + wc) * 64 + fq * 16 + fr;
                if (t < 256) { const int head = (pn - 4) * 2 + (t >> 7), b = u.pm >> 4, blk = u.pm & 15;
                    ((bf16_t*)kmean)[((size_t)(b * 8 + head) * 16 + blk) * 128 + (t & 127)] = (bf16_t)(cvt_pk_bf16((KS[t] + KS[256 + t]) * (1.0f / 256.0f), 0.f) & 0xffffu); }
            }
        } else {
#pragma unroll
            for (int ai = 0; ai < 2; ++ai)
#pragma unroll
                for (int m = 0; m < 4; ++m) { const int row = row0 + ai * HALF + m * 16; const float r = rsc.get(ai, m, fr);
#pragma unroll
                    for (int bj = 0; bj < 2; ++bj) { f32x4 v0 = acc[ai][bj][m][0] * r, v1 = acc[ai][bj][m][1] * r;
                        if (pn >= 12) {
#pragma unroll
                            for (int j = 0; j < 4; ++j) { v0[j] = gelu_f(v0[j]); v1[j] = gelu_f(v1[j]); } }
                        u32x4 w; w.x = cvt_pk_bf16(v0[0], v0[1]); w.y = cvt_pk_bf16(v0[2], v0[3]); w.z = cvt_pk_bf16(v1[0], v1[1]); w.w = cvt_pk_bf16(v1[2], v1[3]);
                        bf16_t* p = (pn < 12) ? V + (size_t)row * 1024 + (pn - 8) * BM + bj * HALF + cw : UG + (size_t)row * 2048 + (pn - 12) * BM + bj * HALF + cw;
                        *(u32x4*)p = w; } }
        }
    }
};
struct EpiVUG {
    static constexpr bool PERM = true, AFTER_DRAIN = false, MIDK = false;
    bf16_t* V; bf16_t* UG; const float* ss; float post;
    __device__ __forceinline__ void operator()(const f32x4 (&acc)[2][2][4][2], const Unit& u, int wr, int wc, int fr, int fq) const {
        const int row0 = u.pm * BM + wr * 64 + fr, cw = wc * 32 + 8 * fq, pn = u.pn;
        RowScales rsc; rsc.load(ss, row0, fq, post);
#pragma unroll
        for (int ai = 0; ai < 2; ++ai)
#pragma unroll
            for (int m = 0; m < 4; ++m) { const int row = row0 + ai * HALF + m * 16; const float r = rsc.get(ai, m, fr);
#pragma unroll
                for (int bj = 0; bj < 2; ++bj) { f32x4 v0 = acc[ai][bj][m][0] * r, v1 = acc[ai][bj][m][1] * r;
                    if (pn >= 4) {
                        typedef float f2 __attribute__((ext_vector_type(2)));
                        f2 z[4] = {{v0[0], v0[1]}, {v0[2], v0[3]}, {v1[0], v1[1]}, {v1[2], v1[3]}}, t[4];
#pragma unroll
                        for (int k = 0; k < 4; ++k) t[k] = (z[k] * z[k]) * 0.044715f + 1.0f;
#pragma unroll
                        for (int k = 0; k < 4; ++k) t[k] = (z[k] * t[k]) * -2.302208198f;
#pragma unroll
                        for (int k = 0; k < 4; ++k) { t[k].x = __builtin_amdgcn_exp2f(t[k].x); t[k].y = __builtin_amdgcn_exp2f(t[k].y); }
#pragma unroll
                        for (int k = 0; k < 4; ++k) t[k] = t[k] + 1.0f;
#pragma unroll
                        for (int k = 0; k < 4; ++k) { t[k].x = __builtin_amdgcn_rcpf(t[k].x); t[k].y = __builtin_amdgcn_rcpf(t[k].y); }
#pragma unroll
                        for (int k = 0; k < 4; ++k) z[k] = z[k] * t[k];
                        v0 = (f32x4){z[0].x, z[0].y, z[1].x, z[1].y}; v1 = (f32x4){z[2].x, z[2].y, z[3].x, z[3].y}; }
                    u32x4 w; w.x = cvt_pk_bf16(v0[0], v0[1]); w.y = cvt_pk_bf16(v0[2], v0[3]); w.z = cvt_pk_bf16(v1[0], v1[1]); w.w = cvt_pk_bf16(v1[2], v1[3]);
                    bf16_t* p = (pn < 4) ? V + (size_t)row * 1024 + pn * BM + bj * HALF + cw : UG + (size_t)row * 2048 + (pn - 4) * BM + bj * HALF + cw;
                    *(u32x4*)p = w; } }
    }
};
template <bool BASE16, bool MIDK_ = false> struct EpiResid {
    static constexpr bool PERM = true, AFTER_DRAIN = true, MIDK = MIDK_;
    const void* base; float* out; bf16_t* xb; unsigned char* x8; float* ss; float alpha; const PG8_LAS float* tbl;
    __device__ __forceinline__ void midk(f32x4 (&acc)[2][2][4][2], int wr, int fr) const {
#pragma unroll
        for (int ai = 0; ai < 2; ++ai)
#pragma unroll
            for (int m = 0; m < 4; ++m) { const float ra = tbl[(ai * HALF + wr * 64 + m * 16 + fr) * 2];
#pragma unroll
                for (int bj = 0; bj < 2; ++bj)
#pragma unroll
                    for (int n = 0; n < 2; ++n) acc[ai][bj][m][n] *= ra; }
    }
    __device__ __forceinline__ void fused(f32x4 (&acc)[2][2][4][2], const Unit& u, int wr, int wc, int fr, int fq, PG8_LAS unsigned char* lds, int wid, int lane) const {
        typedef unsigned u32x2v __attribute__((ext_vector_type(2)));
        PG8_LAS float* P = (PG8_LAS float*)lds;
        const int col0 = u.pn * BM + wc * 32 + 8 * fq;
        u32x4 rw[2][2][2]; f32x4 rf[2][2][2][2];
#define ER_LOAD(g_) do { _Pragma("unroll") for (int mi = 0; mi < 2; ++mi) _Pragma("unroll") for (int bj = 0; bj < 2; ++bj) { \
            const int rl_ = ((g_) >> 1) * HALF + wr * 64 + (2 * ((g_) & 1) + mi) * 16 + fr; const size_t o2_ = (size_t)(u.pm * BM + rl_) * DMODEL + col0 + bj * HALF; \
            if constexpr (BASE16) rw[(g_) & 1][mi][bj] = *(const u32x4*)((const bf16_t*)base + o2_); \
            else { rf[(g_) & 1][mi][bj][0] = __builtin_nontemporal_load((const f32x4*)((const float*)base + o2_)); rf[(g_) & 1][mi][bj][1] = __builtin_nontemporal_load((const f32x4*)((const float*)base + o2_ + 4)); } } } while (0)
        ER_LOAD(0); __builtin_amdgcn_sched_barrier(0);
#pragma unroll
        for (int g = 0; g < 4; ++g) {
            if (g + 1 < 4) { ER_LOAD(g + 1); __builtin_amdgcn_sched_barrier(0); }
            const int ai = g >> 1;
#pragma unroll
            for (int mi = 0; mi < 2; ++mi) { const int m = 2 * (g & 1) + mi; const int rl = ai * HALF + wr * 64 + m * 16 + fr; const size_t off = (size_t)(u.pm * BM + rl) * DMODEL + col0; float q = 0.f;
                const float al = MIDK_ ? alpha * tbl[rl * 2 + 1] : alpha;
#pragma unroll
                for (int bj = 0; bj < 2; ++bj) { const size_t o2 = off + bj * HALF; f32x4 b0, b1;
                    if constexpr (BASE16) { const u32x4 w = rw[g & 1][mi][bj];
                        b0 = (f32x4){__uint_as_float(w.x << 16), __uint_as_float(w.x & 0xffff0000u), __uint_as_float(w.y << 16), __uint_as_float(w.y & 0xffff0000u)};
                        b1 = (f32x4){__uint_as_float(w.z << 16), __uint_as_float(w.z & 0xffff0000u), __uint_as_float(w.w << 16), __uint_as_float(w.w & 0xffff0000u)}; }
                    else { b0 = rf[g & 1][mi][bj][0]; b1 = rf[g & 1][mi][bj][1]; }
                    const f32x4 v0 = b0 + acc[ai][bj][m][0] * al, v1 = b1 + acc[ai][bj][m][1] * al;
                    if (out) { PG8_LAS float* tp_ = (PG8_LAS float*)lds + (wr * 32 + mi * 16 + fr) * 260 + bj * HALF + wc * 32 + 8 * fq; *(PG8_LAS f32x4*)tp_ = v0; *(PG8_LAS f32x4*)(tp_ + 4) = v1; }
                    if (xb) { u32x4 w; w.x = cvt_pk_bf16(v0[0], v0[1]); w.y = cvt_pk_bf16(v0[2], v0[3]); w.z = cvt_pk_bf16(v1[0], v1[1]); w.w = cvt_pk_bf16(v1[2], v1[3]);
                        *(PG8_LAS u32x4*)(lds + 8192 + (wr * 32 + mi * 16 + fr) * 528 + (bj * HALF + wc * 32 + 8 * fq) * 2) = w; }
                    if (x8) { u32x2v w; w.x = cvt_pk4_fp8(v0[0], v0[1], v0[2], v0[3]); w.y = cvt_pk4_fp8(v1[0], v1[1], v1[2], v1[3]);
                        *(PG8_LAS u32x2v*)(lds + 43008 + (wr * 32 + mi * 16 + fr) * 272 + (bj * HALF + wc * 32 + 8 * fq)) = w; }
                    q += ((v0[0] * v0[0] + v0[1] * v0[1]) + (v0[2] * v0[2] + v0[3] * v0[3])) + ((v1[0] * v1[0] + v1[1] * v1[1]) + (v1[2] * v1[2] + v1[3] * v1[3])); }
                if (ss) { q += __shfl_xor(q, 16); q += __shfl_xor(q, 32); if (fq == 0) P[rl * 4 + wc] = q; } }
            if (out) {
                asm volatile("s_waitcnt lgkmcnt(0)" ::: "memory"); __builtin_amdgcn_s_barrier(); asm volatile("" ::: "memory");
#pragma unroll
                for (int j = 0; j < 8; ++j) { const int row = wid * 8 + j; const f32x4 v = *(const PG8_LAS f32x4*)((const PG8_LAS float*)lds + row * 260 + 4 * lane);
                    const int rl = ai * HALF + (row >> 5) * 64 + (2 * (g & 1) + ((row >> 4) & 1)) * 16 + (row & 15);
                    __builtin_nontemporal_store(v, (f32x4*)(out + (size_t)(u.pm * BM + rl) * DMODEL + u.pn * BM + 4 * lane)); }
                asm volatile("s_waitcnt lgkmcnt(0)" ::: "memory"); __builtin_amdgcn_s_barrier(); asm volatile("" ::: "memory");
            }
            if (xb) {
                asm volatile("s_waitcnt lgkmcnt(0)" ::: "memory"); __builtin_amdgcn_s_barrier(); asm volatile("" ::: "memory");
#pragma unroll
                for (int j = 0; j < 4; ++j) { const int row = wid * 8 + 2 * j + (lane >> 5); const u32x4 v = *(const PG8_LAS u32x4*)(lds + 8192 + row * 528 + (lane & 31) * 16);
                    const int rl = ai * HALF + (row >> 5) * 64 + (2 * (g & 1) + ((row >> 4) & 1)) * 16 + (row & 15);
                    *(u32x4*)(xb + (size_t)(u.pm * BM + rl) * DMODEL + u.pn * BM + (lane & 31) * 8) = v; }
                if (x8) {
#pragma unroll
                    for (int j = 0; j < 2; ++j) { const int row = wid * 8 + 4 * j + (lane >> 4); const u32x4 v = *(const PG8_LAS u32x4*)(lds + 43008 + row * 272 + (lane & 15) * 16);
                        const int rl = ai * HALF + (row >> 5) * 64 + (2 * (g & 1) + ((row >> 4) & 1)) * 16 + (row & 15);
                        *(u32x4*)(x8 + (size_t)(u.pm * BM + rl) * DMODEL + u.pn * BM + (lane & 15) * 16) = v; } }
                asm volatile("s_waitcnt lgkmcnt(0)" ::: "memory"); __builtin_amdgcn_s_barrier(); asm volatile("" ::: "memory");
            }
            __builtin_amdgcn_sched_barrier(0);
        }
#undef ER_LOAD
        if (ss) {
            asm volatile("s_waitcnt lgkmcnt(0)" ::: "memory"); __builtin_amdgcn_s_barrier(); asm volatile("" ::: "memory");
            const int t = wid * 64 + lane;
            if (t < 256) { const f32x4 p = *(const PG8_LAS f32x4*)(P + t * 4); ss[(size_t)(u.pm * BM + t) * 8 + u.pn] = (p[0] + p[1]) + (p[2] + p[3]); }
        }
    }
};

template <class Epi, class Sched, bool ALIGN_EPI = false, bool SP2 = false, bool F8 = false>
__device__ __forceinline__ void gemm_phase(PG8_LAS unsigned char* lds, const Gemm g, const Sched& S, const Epi& E, const int wid) {
    const int lane = mk_lane(), tid = wid * 64 + lane, wr = wid >> 2, wc = wid & 3, fr = lane & 15, fq = lane >> 4;
    const int K = g.K, nt = K / BK;
    unsigned voffA[2], voffB[2];
#pragma unroll
    for (int i = 0; i < 2; ++i) { int R, C; stage_rc(tid * 16 + i * 8192, R, C); const int Rb = Epi::PERM ? ((R & ~31) + perm32(R & 31)) : R;
        voffA[i] = (unsigned)(R * K + C) * 2u; voffB[i] = (unsigned)(Rb * K + C) * 2u; }
    const unsigned kstep = (unsigned)(BK * 2);
    const unsigned hstep = (unsigned)HALF * K * 2;
    const unsigned tstep = 2 * hstep;
    const unsigned ldsw = (unsigned)wid * 1024u;
    const int aoff = lds_byte(wr * 64 + fr, fq * 8), boff = lds_byte(wc * 32 + fr, fq * 8);
#define PG8_SA(b, h) (((b) * 2 + (h)) * HTB)
#define PG8_SB(b, h) ((4 + (b) * 2 + (h)) * HTB)
    const __amdgpu_buffer_rsrc_t rsA = __builtin_amdgcn_make_buffer_rsrc((void*)g.A, 0, (int)((unsigned)g.M * (unsigned)K * 2u), 0x00020000);
    const __amdgpu_buffer_rsrc_t rsB = __builtin_amdgcn_make_buffer_rsrc((void*)g.Bt, 0, (int)((unsigned)g.N * (unsigned)K * 2u), 0x00020000);
#define PG8_STAGE(bufoff, soff, voff, rs) do { _Pragma("unroll") for (int _i = 0; _i < 2; ++_i) \
        __builtin_amdgcn_raw_ptr_buffer_load_lds(rs, (PG8_LAS void*)(lds + (bufoff) + ldsw + _i * 8192), 16, (int)(voff)[_i], (int)(soff), 0, 0); } while (0)
#define PG8_LDA(dst, b, h) do { _Pragma("unroll") for (int m = 0; m < 4; ++m) _Pragma("unroll") for (int k = 0; k < 2; ++k) dst[m][k] = *(const PG8_LAS bf16x8*)(lds + PG8_SA(b, h) + aoff + m * 2048 + k * 1024); } while (0)
#define PG8_LDB(dst, b, h) do { _Pragma("unroll") for (int n = 0; n < 2; ++n) _Pragma("unroll") for (int k = 0; k < 2; ++k) dst[n][k] = *(const PG8_LAS bf16x8*)(lds + PG8_SB(b, h) + boff + n * 2048 + k * 1024); } while (0)
#define PG8_CAT(v) __builtin_shufflevector(__builtin_bit_cast(i32x4, (v)[0]), __builtin_bit_cast(i32x4, (v)[1]), 0, 1, 2, 3, 4, 5, 6, 7)
#define PG8_MMA(ai, bj, At, Bt) do { __builtin_amdgcn_s_setprio(1); if constexpr (F8) { _Pragma("unroll") for (int m = 0; m < 4; ++m) _Pragma("unroll") for (int n = 0; n < 2; ++n) \
        acc[ai][bj][m][n] = __builtin_amdgcn_mfma_scale_f32_16x16x128_f8f6f4(PG8_CAT(Bt[n]), PG8_CAT(At[m]), acc[ai][bj][m][n], 0, 0, 0, 0, 0, 0); } else { \
        _Pragma("unroll") for (int m = 0; m < 4; ++m) _Pragma("unroll") for (int n = 0; n < 2; ++n) _Pragma("unroll") for (int k = 0; k < 2; ++k) \
        acc[ai][bj][m][n] = __builtin_amdgcn_mfma_f32_16x16x32_bf16(Bt[n][k], At[m][k], acc[ai][bj][m][n], 0, 0, 0); } __builtin_amdgcn_s_setprio(0); } while (0)
#define PG8_WAIT_V(n) asm volatile("s_waitcnt vmcnt(" #n ")" ::: "memory")
#define PG8_WAIT_L(n) asm volatile("s_waitcnt lgkmcnt(" #n ")" ::: "memory")
#define PG8_BAR __builtin_amdgcn_s_barrier()
#define PG8_SCHED __builtin_amdgcn_sched_barrier(0)
    Unit cur, nxt; int ui = 0;
    if (!S.next(0, cur)) return;
    f32x4 acc[2][2][4][2];
#pragma unroll
    for (int a = 0; a < 2; ++a)
#pragma unroll
        for (int b = 0; b < 2; ++b)
#pragma unroll
            for (int m = 0; m < 4; ++m)
#pragma unroll
                for (int n = 0; n < 2; ++n) acc[a][b][m][n] = (f32x4){0.f, 0.f, 0.f, 0.f};
    bf16x8 At[4][2], B0[2][2], B1[2][2];
    unsigned cA = (unsigned)cur.pm * tstep, cB = (unsigned)cur.pn * tstep;
    S.a_ready(cur);
    if constexpr (SP2) {
        PG8_STAGE(PG8_SB(0, 0), cB, voffB, rsB); PG8_STAGE(PG8_SB(0, 1), cB + hstep, voffB, rsB); PG8_STAGE(PG8_SA(0, 0), cA, voffA, rsA); PG8_STAGE(PG8_SA(0, 1), cA + hstep, voffA, rsA);
        if (wr == 1) PG8_BAR;
        PG8_WAIT_V(2); PG8_BAR;
        PG8_STAGE(PG8_SB(1, 0), cB + kstep, voffB, rsB); PG8_STAGE(PG8_SA(1, 0), cA + kstep, voffA, rsA); PG8_STAGE(PG8_SB(1, 1), cB + hstep + kstep, voffB, rsB);
        PG8_WAIT_V(6); PG8_BAR;
    } else {
        PG8_STAGE(PG8_SB(0, 0), cB, voffB, rsB); PG8_STAGE(PG8_SA(0, 0), cA, voffA, rsA); PG8_STAGE(PG8_SB(0, 1), cB + hstep, voffB, rsB); PG8_STAGE(PG8_SA(0, 1), cA + hstep, voffA, rsA);
        if (wr == 1) PG8_BAR;
        PG8_WAIT_V(4); PG8_BAR;
        PG8_STAGE(PG8_SB(1, 0), cB + kstep, voffB, rsB); PG8_STAGE(PG8_SA(1, 0), cA + kstep, voffA, rsA); PG8_STAGE(PG8_SB(1, 1), cB + hstep + kstep, voffB, rsB);
        PG8_WAIT_V(6); PG8_BAR;
    }
    for (;;) {
        const bool has_next = S.next(ui + 1, nxt);
        const unsigned nA = has_next ? (unsigned)nxt.pm * tstep : cA, nB = has_next ? (unsigned)nxt.pn * tstep : cB;
        for (int t = 0; t < nt; t += 2) {
            if constexpr (Epi::MIDK) { if (t == (nt >> 1)) E.midk(acc, wr, mk_lane() & 15); }
            const bool last = (t == nt - 2);
            const unsigned a1 = cA + (unsigned)(t + 1) * kstep;
            const unsigned a2 = last ? nA : cA + (unsigned)(t + 2) * kstep, b2 = last ? nB : cB + (unsigned)(t + 2) * kstep;
            const unsigned a3 = a2 + kstep, b3 = b2 + kstep;
            if (last && has_next) S.a_ready(nxt);
            if constexpr (SP2) {
            PG8_LDB(B0, 0, 0); PG8_LDB(B1, 0, 1); PG8_SCHED; PG8_LDA(At, 0, 0); PG8_STAGE(PG8_SA(1, 1), a1 + hstep, voffA, rsA);
            PG8_WAIT_V(8); PG8_WAIT_L(0); PG8_BAR; PG8_MMA(0, 0, At, B0); PG8_MMA(0, 1, At, B1); PG8_BAR; PG8_SCHED;
            PG8_LDA(At, 0, 1); PG8_STAGE(PG8_SB(0, 0), b2, voffB, rsB); PG8_STAGE(PG8_SB(0, 1), b2 + hstep, voffB, rsB); PG8_STAGE(PG8_SA(0, 0), a2, voffA, rsA);
            PG8_WAIT_V(8); PG8_WAIT_L(0); PG8_BAR; PG8_MMA(1, 0, At, B0); PG8_MMA(1, 1, At, B1); PG8_BAR; PG8_SCHED;
            PG8_LDB(B0, 1, 0); PG8_LDB(B1, 1, 1); PG8_SCHED; PG8_LDA(At, 1, 0); PG8_STAGE(PG8_SA(0, 1), a2 + hstep, voffA, rsA);
            PG8_WAIT_V(8); PG8_WAIT_L(0); PG8_BAR; PG8_MMA(0, 0, At, B0); PG8_MMA(0, 1, At, B1); PG8_BAR; PG8_SCHED;
            PG8_LDA(At, 1, 1); PG8_STAGE(PG8_SB(1, 0), b3, voffB, rsB); PG8_STAGE(PG8_SB(1, 1), b3 + hstep, voffB, rsB); PG8_STAGE(PG8_SA(1, 0), a3, voffA, rsA);
            PG8_WAIT_V(8); PG8_WAIT_L(0); PG8_BAR; PG8_MMA(1, 0, At, B0); PG8_MMA(1, 1, At, B1); PG8_BAR; PG8_SCHED;
            } else {
            PG8_LDB(B0, 0, 0); PG8_SCHED; PG8_LDA(At, 0, 0); PG8_STAGE(PG8_SA(1, 1), a1 + hstep, voffA, rsA);
            PG8_WAIT_L(8); PG8_BAR; PG8_WAIT_L(0); PG8_MMA(0, 0, At, B0); PG8_BAR; PG8_SCHED;
            PG8_LDB(B1, 0, 1); PG8_STAGE(PG8_SB(0, 0), b2, voffB, rsB);
            PG8_BAR; PG8_WAIT_L(0); PG8_MMA(0, 1, At, B1); PG8_BAR;
            PG8_LDA(At, 0, 1); PG8_STAGE(PG8_SA(0, 0), a2, voffA, rsA);
            PG8_BAR; PG8_WAIT_L(0); PG8_MMA(1, 0, At, B0); PG8_BAR; PG8_SCHED;
            PG8_STAGE(PG8_SB(0, 1), b2 + hstep, voffB, rsB);
            PG8_WAIT_V(6); PG8_BAR; PG8_MMA(1, 1, At, B1); PG8_BAR;
            PG8_LDB(B0, 1, 0); PG8_SCHED; PG8_LDA(At, 1, 0); PG8_STAGE(PG8_SA(0, 1), a2 + hstep, voffA, rsA);
            PG8_WAIT_L(8); PG8_BAR; PG8_WAIT_L(0); PG8_MMA(0, 0, At, B0); PG8_BAR; PG8_SCHED;
            PG8_LDB(B1, 1, 1); PG8_STAGE(PG8_SB(1, 0), b3, voffB, rsB);
            PG8_BAR; PG8_WAIT_L(0); PG8_MMA(0, 1, At, B1); PG8_BAR;
            PG8_LDA(At, 1, 1); PG8_STAGE(PG8_SA(1, 0), a3, voffA, rsA);
            PG8_BAR; PG8_WAIT_L(0); PG8_MMA(1, 0, At, B0); PG8_BAR; PG8_SCHED;
            PG8_STAGE(PG8_SB(1, 1), b3 + hstep, voffB, rsB);
            PG8_WAIT_V(6); PG8_BAR; PG8_MMA(1, 1, At, B1); PG8_BAR;
            }
        }
        if constexpr (ALIGN_EPI) { if (wr == 0) PG8_BAR; }
        if constexpr (!Epi::AFTER_DRAIN) { const int l2_ = mk_lane(); E(acc, cur, wr, wc, l2_ & 15, l2_ >> 4); S.done(cur); }
        if (!has_next) break;
#pragma unroll
        for (int a = 0; a < 2; ++a)
#pragma unroll
            for (int b = 0; b < 2; ++b)
#pragma unroll
                for (int m = 0; m < 4; ++m)
#pragma unroll
                    for (int n = 0; n < 2; ++n) acc[a][b][m][n] = (f32x4){0.f, 0.f, 0.f, 0.f};
        cur = nxt; cA = nA; cB = nB; ++ui;
        if constexpr (ALIGN_EPI) { if (wr == 1) PG8_BAR; }
    }
    PG8_WAIT_V(0);
    if constexpr (!ALIGN_EPI) { if (wr == 0) PG8_BAR; }
    PG8_BAR;
    if constexpr (Epi::AFTER_DRAIN) { const int l2_ = mk_lane(); E.fused(acc, cur, wr, wc, l2_ & 15, l2_ >> 4, lds, wid, l2_); S.done(cur); }
#undef PG8_SA
#undef PG8_SB
#undef PG8_STAGE
#undef PG8_LDA
#undef PG8_LDB
#undef PG8_MMA
#undef PG8_CAT
#undef PG8_WAIT_V
#undef PG8_WAIT_L
#undef PG8_BAR
#undef PG8_SCHED
}
}

namespace att {
#define ALDS __attribute__((address_space(3)))
typedef short bf16x8 __attribute__((ext_vector_type(8)));
typedef short s16x4 __attribute__((ext_vector_type(4)));
typedef float f32x16 __attribute__((ext_vector_type(16)));
typedef float f32x4 __attribute__((ext_vector_type(4)));
typedef unsigned u32x4 __attribute__((ext_vector_type(4)));
constexpr int NW = 8, QBLK = 32, KVBLK = 64, D = 128, SEQ = 4096, NHEAD = 8;
constexpr int SHM_V = KVBLK * D * 2, SHM_K = KVBLK * D * 2;
constexpr int OFF_V = 0, OFF_K = 2 * SHM_V, OFF_WS = 2 * SHM_V + 2 * SHM_K, ATT_LDS = OFF_WS + NW * 64 * 4;
constexpr size_t QK_PITCH = 4096;
#define KSWZ(row, colB) ((row) * 256 + ((colB) ^ (((row) & 7) << 4)))
#define SBAR() __builtin_amdgcn_sched_barrier(0)
__device__ __forceinline__ int v_st(int k, int c) { const int kk = (k & ~0xC) | ((k & 4) << 1) | ((k & 8) >> 1); return ((kk >> 3) * 4 + (c >> 5)) * 512 + ((kk & 7) * 32 + (c & 31)) * 2; }
__device__ __forceinline__ int v_rd_base(int lane) { return ((lane & 3) << 3) | (((lane >> 2) & 3) << 6) | (((lane >> 4) & 1) << 5) | (((lane >> 5) & 1) << 8); }
constexpr int v_rd_off(int d0, int ks, int half) { return d0 * 512 + ks * 4096 + half * 2048; }
__device__ __forceinline__ int crow(int r, int hi) { return (r & 3) + 8 * (r >> 2) + 4 * hi; }
__device__ __forceinline__ unsigned cvtpk(float lo, float hi) { unsigned r; asm volatile("v_cvt_pk_bf16_f32 %0, %1, %2" : "=v"(r) : "v"(lo), "v"(hi)); return r; }
constexpr float THR2 = 11.5f;

__device__ __forceinline__ void partialSM(f32x16& p0, f32x16& p1, float& m_reg, float& alpha, float& dl) {
    float pmax = p0[0];
#pragma unroll
    for (int r = 1; r < 16; ++r) pmax = fmaxf(pmax, p0[r]);
#pragma unroll
    for (int r = 0; r < 16; ++r) pmax = fmaxf(pmax, p1[r]);
    { auto rr = __builtin_amdgcn_permlane32_swap(__float_as_uint(pmax), __float_as_uint(pmax), false, false);
      pmax = fmaxf(__uint_as_float(rr[0]), __uint_as_float(rr[1])); }
    alpha = 1.f; dl = 0.f;
    if (__builtin_expect(!__all(pmax <= THR2), 0)) { dl = fmaxf(pmax, 0.f); alpha = __builtin_amdgcn_exp2f(-dl); m_reg += dl;
#pragma unroll
        for (int r = 0; r < 16; ++r) { p0[r] -= dl; p1[r] -= dl; } }
#pragma unroll
    for (int r = 0; r < 16; ++r) p0[r] = __builtin_amdgcn_exp2f(p0[r]);
#pragma unroll
    for (int r = 0; r < 16; ++r) p1[r] = __builtin_amdgcn_exp2f(p1[r]);
}
__device__ __forceinline__ void finishSM(f32x16& p0, f32x16& p1, float alpha, float& l_reg, bf16x8& pa0, bf16x8& pa1, bf16x8& pa2, bf16x8& pa3) {
    float ps = 0;
#pragma unroll
    for (int r = 0; r < 16; ++r) ps += p0[r];
#pragma unroll
    for (int r = 0; r < 16; ++r) ps += p1[r];
    { auto rr = __builtin_amdgcn_permlane32_swap(__float_as_uint(ps), __float_as_uint(ps), false, false);
      ps = __uint_as_float(rr[0]) + __uint_as_float(rr[1]); }
    l_reg = l_reg * alpha + ps;
#define PK4(P, B_, OUT) do { unsigned a0 = cvtpk(P[B_+0], P[B_+1]), a1 = cvtpk(P[B_+2], P[B_+3]);                          \
        unsigned b0 = cvtpk(P[B_+4], P[B_+5]), b1 = cvtpk(P[B_+6], P[B_+7]);                                             \
        auto r0 = __builtin_amdgcn_permlane32_swap(a0, b0, false, false); auto r1 = __builtin_amdgcn_permlane32_swap(a1, b1, false, false); \
        u32x4 w = {r0[0], r1[0], r0[1], r1[1]}; OUT = __builtin_bit_cast(bf16x8, w); } while (0)
    PK4(p0, 0, pa0); PK4(p0, 8, pa1); PK4(p1, 0, pa2); PK4(p1, 8, pa3);
#undef PK4
}
__device__ __forceinline__ void qkt(f32x16& p0, f32x16& p1, const ALDS char* Kt, int r32, int hi, const bf16x8* qr, float c0) {
#pragma unroll
    for (int r = 0; r < 16; ++r) { p0[r] = c0; p1[r] = c0; }
    int kb[4];
#pragma unroll
    for (int dd = 0; dd < 4; ++dd) kb[dd] = (int)(uintptr_t)Kt + KSWZ(r32, (dd * 16 + hi * 8) * 2);
#define KRD(dst, d0, hf) asm volatile("ds_read_b128 %0, %1 offset:%2" : "=v"(dst) : "v"(kb[(d0) & 3]), "i"(((d0) >> 2) * 128 + (hf) * 8192) : "memory")
#define KBATCH(f, g) do { KRD(f[0], 2 * (g), 0); KRD(f[1], 2 * (g), 1); KRD(f[2], 2 * (g) + 1, 0); KRD(f[3], 2 * (g) + 1, 1); } while (0)
#define KMMA(f, g) do { p0 = __builtin_amdgcn_mfma_f32_32x32x16_bf16(f[0], qr[2 * (g)], p0, 0, 0, 0); p1 = __builtin_amdgcn_mfma_f32_32x32x16_bf16(f[1], qr[2 * (g)], p1, 0, 0, 0); \
                        p0 = __builtin_amdgcn_mfma_f32_32x32x16_bf16(f[2], qr[2 * (g) + 1], p0, 0, 0, 0); p1 = __builtin_amdgcn_mfma_f32_32x32x16_bf16(f[3], qr[2 * (g) + 1], p1, 0, 0, 0); } while (0)
#define KWAIT() do { asm volatile("s_waitcnt lgkmcnt(0)" ::: "memory"); SBAR(); } while (0)
    bf16x8 fa[4], fb[4];
    __builtin_amdgcn_s_setprio(1);
    KBATCH(fa, 0); KWAIT();
    KBATCH(fb, 1); SBAR(); KMMA(fa, 0); SBAR(); KWAIT();
    KBATCH(fa, 2); SBAR(); KMMA(fb, 1); SBAR(); KWAIT();
    KBATCH(fb, 3); SBAR(); KMMA(fa, 2); SBAR(); KWAIT();
    KMMA(fb, 3);
    __builtin_amdgcn_s_setprio(0);
#undef KRD
#undef KBATCH
#undef KMMA
#undef KWAIT
}
template <int HALF>
__device__ __forceinline__ void pv_tile(f32x16* o, int vb, bf16x8 pa0, bf16x8 pa1, bf16x8 pa2, bf16x8 pa3) {
#define TRRD(dst, off) asm volatile("ds_read_b64_tr_b16 %0, %1 offset:%2" : "=&v"(dst) : "v"(vb), "i"(off) : "memory")
#define PV_D0(d0) do { s16x4 l0, l1, l2, l3, h0, h1, h2, h3; constexpr int b_ = v_rd_off(d0, 0, 0); \
        TRRD(l0, b_); TRRD(h0, b_ + 2048); TRRD(l1, b_ + 4096); TRRD(h1, b_ + 6144); TRRD(l2, b_ + 8192); TRRD(h2, b_ + 10240); TRRD(l3, b_ + 12288); TRRD(h3, b_ + 14336); \
        asm volatile("s_waitcnt lgkmcnt(0)" ::: "memory"); SBAR();   \
        o[d0] = __builtin_amdgcn_mfma_f32_32x32x16_bf16(pa0, (bf16x8){l0[0], l0[1], l0[2], l0[3], h0[0], h0[1], h0[2], h0[3]}, o[d0], 0, 0, 0);   \
        o[d0] = __builtin_amdgcn_mfma_f32_32x32x16_bf16(pa1, (bf16x8){l1[0], l1[1], l1[2], l1[3], h1[0], h1[1], h1[2], h1[3]}, o[d0], 0, 0, 0);   \
        o[d0] = __builtin_amdgcn_mfma_f32_32x32x16_bf16(pa2, (bf16x8){l2[0], l2[1], l2[2], l2[3], h2[0], h2[1], h2[2], h2[3]}, o[d0], 0, 0, 0);   \
        o[d0] = __builtin_amdgcn_mfma_f32_32x32x16_bf16(pa3, (bf16x8){l3[0], l3[1], l3[2], l3[3], h3[0], h3[1], h3[2], h3[3]}, o[d0], 0, 0, 0); } while (0)
    __builtin_amdgcn_s_setprio(1); if (HALF == 0) { PV_D0(0); PV_D0(1); } else { PV_D0(2); PV_D0(3); } __builtin_amdgcn_s_setprio(0);
#undef PV_D0
#undef TRRD
}

constexpr int GRP_LDS = 65536;
constexpr int OFF_SCR = 133120;
__device__ __forceinline__ void attn_unit(int b, int h, int qb, int half, const unsigned char* QKb, const unsigned short* Vb, const float* kmean, unsigned short* O, float* ssa, ALDS unsigned char* lds, int wid) {
    const int lane = mk_lane(), r32 = lane & 31, hi = lane >> 5, grp = wid >> 2, wq = wid & 3, tg = wq * 64 + lane;
    const size_t rowbase = (size_t)b * SEQ;
    const int rblk = half * 128 + wq * QBLK;
    const int qw = qb * 256 + rblk;
    ALDS char* V_lds = (ALDS char*)lds + grp * GRP_LDS; ALDS char* K_lds = V_lds + 2 * SHM_V;
    ALDS float* ws = (ALDS float*)(lds + OFF_SCR) + wid * 64; ALDS float* li_l = ws; ALDS float* al_l = ws + 32;
    const int n_own = 2 * (half + 1), NT = n_own + 4 * qb, NIT = NT >> 1;
    unsigned kvo[4], vvo[4];
#pragma unroll
    for (int j = 0; j < 4; ++j) { const int p = wq * 4 + j;
        { const int row = 4 * p + (lane >> 4), chunk = (lane & 15) ^ (row & 7); kvo[j] = (unsigned)(row * (int)QK_PITCH + chunk * 16); }
        { const int T = 2 * p + (lane >> 5), s_ = lane & 31, kk = (T >> 2) * 8 + (s_ >> 2), k = (kk & ~0xC) | ((kk & 4) << 1) | ((kk & 8) >> 1), c = (T & 3) * 32 + (s_ & 3) * 8; vvo[j] = (unsigned)(k * 2048 + c * 2); } }
    const __amdgpu_buffer_rsrc_t rsK = __builtin_amdgcn_make_buffer_rsrc((void*)(QKb + 2048 + h * 256 + rowbase * QK_PITCH), 0, (int)(SEQ * QK_PITCH), 0x00020000);
    const __amdgpu_buffer_rsrc_t rsV = __builtin_amdgcn_make_buffer_rsrc((void*)((const unsigned char*)Vb + (rowbase * 1024 + h * 128) * 2), 0, SEQ * 2048, 0x00020000);
    const int vb0 = (int)(uintptr_t)V_lds + v_rd_base(lane);
    float m_reg = 0.f, l_reg = 0.f; f32x16 o[4] = {};
#define KEY0(s) ((s) < n_own ? qb * 256 + 64 * (s) : ((s) - n_own) * 64)
#define DMA_K(s, bf) do { const int k0_ = KEY0(s); _Pragma("unroll") for (int j_ = 0; j_ < 4; ++j_) \
        __builtin_amdgcn_raw_ptr_buffer_load_lds(rsK, (ALDS void*)(K_lds + (bf) * SHM_K + (wq * 4 + j_) * 1024), 16, (int)kvo[j_], k0_ * (int)QK_PITCH, 0, 0); } while (0)
#define DMA_V(s, bf) do { const int k0_ = KEY0(s); _Pragma("unroll") for (int j_ = 0; j_ < 4; ++j_) \
        __builtin_amdgcn_raw_ptr_buffer_load_lds(rsV, (ALDS void*)(V_lds + (bf) * SHM_V + (wq * 4 + j_) * 1024), 16, (int)vvo[j_], k0_ * 2048, 0, 0); } while (0)
    DMA_K(grp, 0); DMA_V(grp, 0);
    bf16x8 qr[8];
    { const unsigned char* qp = QKb + (rowbase + qw + r32) * QK_PITCH + h * 256 + hi * 16;
#pragma unroll
      for (int d0 = 0; d0 < 8; ++d0) qr[d0] = *(const bf16x8*)(qp + d0 * 32); }
    unsigned selmask = 0u;
    if (qb > 0) {
        f32x16 g = f32x16{};
        const unsigned short* km = (const unsigned short*)kmean + ((size_t)(b * NHEAD + h) * 16 + (r32 & 15)) * 128 + hi * 8;
#pragma unroll
        for (int d0 = 0; d0 < 8; ++d0) { bf16x8 a = *(const bf16x8*)(km + d0 * 16); if (r32 >= 16) a = (bf16x8){0, 0, 0, 0, 0, 0, 0, 0};
            g = __builtin_amdgcn_mfma_f32_32x32x16_bf16(a, qr[d0], g, 0, 0, 0); }
        float v[8];
#pragma unroll
        for (int r = 0; r < 8; ++r) { const int n = crow(r, hi); v[r] = (n < qb) ? g[r] : -3.0e38f; }
        const int rounds = qb < 3 ? qb : 3;
#pragma unroll
        for (int rd = 0; rd < 3; ++rd) if (rd < rounds) {
            float bv = v[0]; int bi = crow(0, hi);
#pragma unroll
            for (int r = 1; r < 8; ++r) { if (v[r] > bv) { bv = v[r]; bi = crow(r, hi); } }
            const float ov = __shfl_xor(bv, 32); const int oi = __shfl_xor(bi, 32);
            const bool mine = (bv > ov) || (bv == ov && bi < oi);
            const int wi = mine ? bi : oi;
            selmask |= 1u << wi;
#pragma unroll
            for (int r = 0; r < 8; ++r) if (crow(r, hi) == wi) v[r] = -3.0e38f;
        }
    }
    const float NEG = -__builtin_inff();
    asm volatile("s_waitcnt vmcnt(0)" ::: "memory"); __syncthreads();
    f32x16 p0, p1; bf16x8 pa0, pa1, pa2, pa3;
#define ABAR() asm volatile("s_waitcnt lgkmcnt(0)\n\ts_barrier" ::: "memory")
#define MHALF(it_) do { const int i_ = (it_); \
        if (i_ + 1 < NIT) DMA_K(2 * (i_ + 1) + grp, (i_ + 1) & 1); \
        if (i_ > 0 && i_ < NIT) DMA_V(2 * i_ + grp, i_ & 1); \
        if (i_ > 0) pv_tile<0>(o, vb0 + ((i_ - 1) & 1) * SHM_V, pa0, pa1, pa2, pa3); \
        if (i_ < NIT) { const int s_ = 2 * i_ + grp; const bool keep_ = (s_ < n_own) || ((selmask >> ((s_ - n_own) >> 2)) & 1u); \
            qkt(p0, p1, K_lds + (i_ & 1) * SHM_K, r32, hi, qr, keep_ ? -m_reg : NEG); } } while (0)
#define VHALF(it_) do { const int i_ = (it_), s_ = 2 * i_ + grp; \
        if (i_ > 0) pv_tile<1>(o, vb0 + ((i_ - 1) & 1) * SHM_V, pa0, pa1, pa2, pa3); \
        if (s_ < n_own && 64 * s_ + 63 > rblk) { const int dq = rblk + r32 - 64 * s_ - 4 * hi; \
            _Pragma("unroll") for (int r = 0; r < 16; ++r) { const int c = (r & 3) + 8 * (r >> 2); if (c > dq) p0[r] = NEG; if (c + 32 > dq) p1[r] = NEG; } } \
        float alpha, dl_; partialSM(p0, p1, m_reg, alpha, dl_); finishSM(p0, p1, alpha, l_reg, pa0, pa1, pa2, pa3); \
        if (__any(alpha < 1.f)) { if (hi == 0) al_l[r32] = alpha; asm volatile("s_waitcnt lgkmcnt(0)" ::: "memory"); \
            _Pragma("unroll") for (int d_ = 0; d_ < 4; ++d_) _Pragma("unroll") for (int r = 0; r < 16; ++r) o[d_][r] *= al_l[crow(r, hi)]; } \
        asm volatile("s_waitcnt vmcnt(0)" ::: "memory"); } while (0)
    if (grp == 0) {
        for (int it = 0; it < NIT; ++it) { MHALF(it); ABAR(); VHALF(it); ABAR(); }
        MHALF(NIT); ABAR(); pv_tile<1>(o, vb0 + ((NIT - 1) & 1) * SHM_V, pa0, pa1, pa2, pa3); ABAR();
    } else {
        ABAR();
        for (int it = 0; it < NIT; ++it) { MHALF(it); ABAR(); VHALF(it); ABAR(); }
        MHALF(NIT); ABAR(); pv_tile<1>(o, vb0 + ((NIT - 1) & 1) * SHM_V, pa0, pa1, pa2, pa3);
    }
#undef MHALF
#undef VHALF
#undef ABAR
#undef DMA_K
#undef DMA_V
#undef KEY0
    ALDS float* ex = (ALDS float*)lds + wq * 4096;
    ALDS float* exml = (ALDS float*)(lds + OFF_SCR) + (wq + 4) * 64;
    if (grp == 1) {
        if (hi == 0) { exml[r32] = m_reg; exml[32 + r32] = l_reg; }
#pragma unroll
        for (int d0 = 0; d0 < 4; ++d0)
#pragma unroll
            for (int r = 0; r < 16; ++r) ex[(d0 * 16 + r) * 64 + lane] = o[d0][r];
    }
    asm volatile("s_waitcnt lgkmcnt(0)" ::: "memory"); __syncthreads();
    if (grp == 0) {
        const float m1 = exml[r32], l1 = exml[32 + r32];
        const float mm = fmaxf(m_reg, m1), a0 = __builtin_amdgcn_exp2f(m_reg - mm), a1 = __builtin_amdgcn_exp2f(m1 - mm);
        const float inv = 1.0f / (l_reg * a0 + l1 * a1);
        if (hi == 0) { li_l[r32] = a0 * inv; al_l[r32] = a1 * inv; }
        asm volatile("s_waitcnt lgkmcnt(0)" ::: "memory");
        float f0[16], f1[16];
#pragma unroll
        for (int r = 0; r < 16; ++r) { f0[r] = li_l[crow(r, hi)]; f1[r] = al_l[crow(r, hi)]; }
#pragma unroll
        for (int d0 = 0; d0 < 4; ++d0)
#pragma unroll
            for (int r = 0; r < 16; ++r) o[d0][r] = o[d0][r] * f0[r] + ex[(d0 * 16 + r) * 64 + lane] * f1[r];
    }
    asm volatile("s_waitcnt lgkmcnt(0)" ::: "memory"); __syncthreads();
    if (grp == 0) {
        ALDS unsigned char* stg = (ALDS unsigned char*)(lds + wq * 4096);
#pragma unroll
        for (int r = 0; r < 16; ++r) { const int orow = crow(r, hi);
#pragma unroll
            for (int d0 = 0; d0 < 4; ++d0) { const unsigned w = pg8::cvt_pk4_fp8(16.0f * o[d0][r], 0.f, 0.f, 0.f); stg[orow * 128 + d0 * 32 + r32] = (unsigned char)(w & 0xffu); } }
        asm volatile("s_waitcnt lgkmcnt(0)" ::: "memory");
        unsigned char* Ow = (unsigned char*)O + (rowbase + qw) * 2048 + h * 128;
#pragma unroll
        for (int i = 0; i < 4; ++i) { const int row = i * 8 + (lane >> 3), ch = lane & 7; const u32x4 v = *(const ALDS u32x4*)(stg + row * 128 + ch * 16); *(u32x4*)(Ow + (size_t)row * 2048 + ch * 16) = v;
            float q = 0.f;
#pragma unroll
            for (int e2 = 0; e2 < 4; ++e2) { const float x0 = __builtin_amdgcn_cvt_f32_fp8((int)v[e2], 0), x1 = __builtin_amdgcn_cvt_f32_fp8((int)v[e2], 1), x2 = __builtin_amdgcn_cvt_f32_fp8((int)v[e2], 2), x3 = __builtin_amdgcn_cvt_f32_fp8((int)v[e2], 3);
                q += (x0 * x0 + x1 * x1) + (x2 * x2 + x3 * x3); }
            q += __shfl_xor(q, 1); q += __shfl_xor(q, 2); q += __shfl_xor(q, 4);
            if (ch == 0) ssa[(rowbase + qw + row) * 8 + h] = q; }
    }
    __syncthreads();
}
#undef KSWZ
#undef SBAR
#undef ALDS
}

#define GAS __attribute__((address_space(1)))
#define LAS __attribute__((address_space(3)))
typedef unsigned short bf16;
typedef unsigned v4u __attribute__((ext_vector_type(4)));
typedef float f32x4 __attribute__((ext_vector_type(4)));
typedef short bf16x8 __attribute__((ext_vector_type(8)));
typedef GAS unsigned gu32;
typedef GAS unsigned long long gu64;
#define RLX_AGENT __ATOMIC_RELAXED, __HIP_MEMORY_SCOPE_AGENT
#define LDS_WAIT() asm volatile("s_waitcnt lgkmcnt(0)" ::: "memory")
#define VM_WAIT() asm volatile("s_waitcnt vmcnt(0)" ::: "memory")
__device__ __forceinline__ unsigned long long rt() { return __builtin_amdgcn_s_memrealtime(); }
__device__ __forceinline__ unsigned f2bf(float f) { unsigned u = __builtin_bit_cast(unsigned, f); return (u + 0x7fffu + ((u >> 16) & 1u)) >> 16; }
__device__ __forceinline__ unsigned pk2(float lo, float hi) { return f2bf(lo) | (f2bf(hi) << 16); }

#define XB_TMO      128
#define XB_XCNT(j)  (256  + 64 * (j))
#define XB_XSUB(j)  (1280 + 64 * (j))
#define XB_XGEN(j)  (2304 + 64 * (j))
#define XB_TOP      3328
#define XB_TOPGEN   3392
#define XCD_BAR_WORDS 3456
#define XB_SPIN_CAP (1u << 18)

__device__ __forceinline__ unsigned xb_ld(unsigned* p)              { return __hip_atomic_load(p, __ATOMIC_RELAXED, __HIP_MEMORY_SCOPE_AGENT); }
__device__ __forceinline__ unsigned xb_add(unsigned* p, unsigned v) { return __hip_atomic_fetch_add(p, v, __ATOMIC_RELAXED, __HIP_MEMORY_SCOPE_AGENT); }
__device__ __forceinline__ unsigned xb_xcc_id() { return (unsigned)__builtin_amdgcn_s_getreg((3 << 11) | 20) & 0xFu; }
#define XB_SPIN(cond, bar) do { unsigned _sp = 0; while (cond) { __builtin_amdgcn_s_sleep(1); \
    if ((++_sp & 255u) == 0u) { if (xb_ld(&(bar)[XB_TMO])) break; if (_sp > XB_SPIN_CAP) { atomicAdd(&(bar)[XB_TMO], 1u); break; } } } } while (0)

struct XcdBarrier {
    unsigned* bar; unsigned x;
    volatile LAS unsigned* st;
};

__device__ __forceinline__ XcdBarrier xcd_barrier_post(unsigned* bar, volatile LAS unsigned* st, bool t0) {
    XcdBarrier b; b.bar = bar; b.x = xb_xcc_id(); b.st = st;
    if (t0) (void)xb_add(&bar[XB_XCNT(b.x)], 1u);
    return b;
}
__device__ __forceinline__ void xcd_barrier_complete(unsigned* bar, unsigned x, unsigned& nloc, unsigned& nx) {
    const unsigned G = gridDim.x * gridDim.y * gridDim.z;
    unsigned sum, cnt, mine, sp = 0u;
    for (;;) {
        sum = 0u; cnt = 0u; mine = 0u;
#pragma unroll
        for (unsigned j = 0; j < 16; ++j) { const unsigned c = xb_ld(&bar[XB_XCNT(j)]); sum += c; cnt += (c > 0u) ? 1u : 0u; mine = (j == x) ? c : mine; }
        if (sum == G) break;
        __builtin_amdgcn_s_sleep(1);
        if ((++sp & 255u) == 0u) { if (xb_ld(&bar[XB_TMO])) break; if (sp > XB_SPIN_CAP) { atomicAdd(&bar[XB_TMO], 1u); break; } }
    }
    nloc = mine > 0u ? mine : 1u; nx = cnt > 0u ? cnt : 1u;
}

__device__ __forceinline__ void xcd_barrier(const XcdBarrier& b, bool t0) {
    asm volatile("s_waitcnt vmcnt(0)" ::: "memory");
    __syncthreads();
    if (t0) {
        unsigned* bar = b.bar;
        __builtin_amdgcn_s_waitcnt(0);
        unsigned nloc = b.st[0], nx = b.st[1];
        if (nloc == 0u) { xcd_barrier_complete(bar, b.x, nloc, nx); b.st[0] = nloc; b.st[1] = nx; }
        const unsigned old = xb_add(&bar[XB_XSUB(b.x)], 1u);
        const unsigned gen = old / nloc;
        if (old + 1u == (gen + 1u) * nloc) {
            __builtin_amdgcn_fence(__ATOMIC_RELEASE, "agent");
            asm volatile("s_waitcnt vmcnt(0)" ::: "memory");
            const unsigned og = xb_add(&bar[XB_TOP], 1u);
            const unsigned tg = og / nx;
            __builtin_amdgcn_fence(__ATOMIC_ACQUIRE, "agent");
            if (og + 1u == (tg + 1u) * nx) xb_add(&bar[XB_TOPGEN], 1u);
            else XB_SPIN(xb_ld(&bar[XB_TOPGEN]) == tg, bar);
            xb_add(&bar[XB_XGEN(b.x)], 1u);
            asm volatile("s_waitcnt vmcnt(0)" ::: "memory");
        } else {
            __builtin_amdgcn_fence(__ATOMIC_ACQUIRE, "agent");
            XB_SPIN(xb_ld(&bar[XB_XGEN(b.x)]) == gen, bar);
            asm volatile("s_waitcnt vmcnt(0)" ::: "memory");
        }
    }
    __syncthreads();
}
constexpr int NWAVES = 8;
#ifndef MK_N_LAUNCHES
#define MK_N_LAUNCHES 1
#endif
constexpr int N_PHASES = 10;
constexpr int N_LAUNCHES = MK_N_LAUNCHES;
static_assert(N_LAUNCHES == 1 || N_LAUNCHES == N_PHASES, "MK_N_LAUNCHES is 1 or N_PHASES");
constexpr int BATCH = 2, SEQ = 4096, DM = 2048, DFF = 5632, NHEAD = 8, HD = 128, DATT = 1024, DSGU = 1024, DIN = 5120, NGRP = 8, CHUNK = 128;
constexpr int M = BATCH * SEQ;
constexpr int N1 = 2 * DFF;
constexpr float EPS = 1e-6f;
constexpr float QSCALE = 0.08838834764831845f * 1.4426950408889634f;
constexpr size_t MiB = 1u << 20;
constexpr size_t WS_CTL = 0, CTL_ZERO_BYTES = 64 * 1024;
constexpr size_t WS_SS1 = 0, WS_SS2 = 256 * 1024, WS_KMEAN = 512 * 1024, WS_SSA = 640 * 1024, WS_SSG = 896 * 1024;
constexpr size_t WS_W1 = 2 * MiB, WS_W2 = 46 * MiB, WS_WIN = 68 * MiB, WS_WOUT = 88 * MiB, WS_W5 = 96 * MiB, WS_W6 = 140 * MiB;
constexpr size_t WS_X1F8 = 178 * MiB;
constexpr size_t WS_XA = 162 * MiB, WS_XB = 194 * MiB;
constexpr size_t WS_ACT = 226 * MiB;
constexpr size_t WS_X2B = 270 * MiB;
constexpr size_t WS_QK = 226 * MiB, WS_V = 290 * MiB, WS_UG = 306 * MiB, WS_MIX = 338 * MiB, WS_END = 370 * MiB;
#ifndef WGM_FF1
#define WGM_FF1 4
#define WGM_RES 2
#define WGM_IN 4
#endif
constexpr int CW_BAR = 4096;
constexpr int G3X_OFF = 137216;
constexpr int RING_BYTES = 131072, LDSCTL_OFF = RING_BYTES, MISC_OFF = LDSCTL_OFF + 320, LDS_BYTES = 147456;

struct Frame {
    LAS unsigned char* lds; volatile LAS unsigned* MISC; gu32* ctl;
    int wave, vcu, G;
};

__device__ __forceinline__ float wave_sum(float v) {
#pragma unroll
    for (int o = 1; o < 64; o <<= 1) v += __shfl_xor(v, o);
    return v;
}
struct P0Mat { const float* W; int K, N; bf16* WT; const float* kg; int mode; int ldk; int f8; int ldn; };
struct P0Job { P0Mat m0, m1, m2, m3; int c0, c1, c2, c3, total; };
__device__ __forceinline__ int p0_cnt(const P0Mat& m) { return (m.K / 128) * (m.N / 64); }
__device__ const float g_ones[64] = {1.f, 1.f, 1.f, 1.f, 1.f, 1.f, 1.f, 1.f, 1.f, 1.f, 1.f, 1.f, 1.f, 1.f, 1.f, 1.f, 1.f, 1.f, 1.f, 1.f, 1.f, 1.f, 1.f, 1.f, 1.f, 1.f, 1.f, 1.f, 1.f, 1.f, 1.f, 1.f, 1.f, 1.f, 1.f, 1.f, 1.f, 1.f, 1.f, 1.f, 1.f, 1.f, 1.f, 1.f, 1.f, 1.f, 1.f, 1.f, 1.f, 1.f, 1.f, 1.f, 1.f, 1.f, 1.f, 1.f, 1.f, 1.f, 1.f, 1.f, 1.f, 1.f, 1.f, 1.f};
struct P0Item { const float* src; unsigned char* dst; const float* kg; int N, K, f8, kstep; };
__device__ __forceinline__ P0Item p0_locate(const P0Job& J, int it, int lane) {
    int r = it; P0Mat mm = J.m0;
    if (r >= J.c0) { r -= J.c0; mm = J.m1; if (r >= J.c1) { r -= J.c1; mm = J.m2; if (r >= J.c2) { r -= J.c2; mm = J.m3; } } }
    const int nblk = mm.N / 64, kb = r / nblk, nb = r - kb * nblk, n0 = 64 * nb, k0 = 128 * kb;
    const int drow0 = mm.mode == 0 ? n0 : 256 * (n0 >> 7) + (n0 & 127) + (mm.mode == 2 ? 128 : 0);
    P0Item I; I.src = mm.W + (size_t)(k0 + 8 * (lane >> 4)) * mm.ldn + n0 + 4 * (lane & 15); I.f8 = mm.f8; I.N = mm.ldn; I.K = mm.ldk * (mm.f8 ? 1 : 2);
    I.dst = (unsigned char*)mm.WT + ((size_t)(drow0 + (lane >> 3)) * mm.ldk + k0) * (mm.f8 ? 1 : 2) + 16 * (lane & 7);
    I.kg = (mm.kg ? mm.kg + k0 : g_ones) + (lane & 31); I.kstep = mm.kg ? 32 : 0; return I;
}
#define P0_LOAD(w, kx, I, t) do { if (MODE == 2) break; _Pragma("unroll") for (int i_ = 0; i_ < 8; ++i_) asm volatile("global_load_dwordx4 %0, %1, off nt" : "=v"(w[i_]) : "v"((I).src + (size_t)(32 * (t) + i_) * (I).N) : "memory"); \
        asm volatile("global_load_dword %0, %1, off" : "=v"(kx) : "v"((I).kg + (I).kstep * (t)) : "memory"); } while (0)
#define P0_TIE(w, kx) "+v"(w[0]), "+v"(w[1]), "+v"(w[2]), "+v"(w[3]), "+v"(w[4]), "+v"(w[5]), "+v"(w[6]), "+v"(w[7]), "+v"(kx)
#define P0_WAIT(w, kx) asm volatile("s_waitcnt vmcnt(27)" : P0_TIE(w, kx) :: "memory")
template <int T>
__device__ __forceinline__ void p0_proc(const f32x4 (&w)[8], const float kgv, const P0Item& I, LAS float* scr, int lane) {
    const int r = lane >> 4, c = lane & 15;
    LAS unsigned char* ot = (LAS unsigned char*)scr + 128;
    scr[lane & 31] = kgv;
    asm volatile("" ::: "memory");
    const f32x4 ga = *(const LAS f32x4*)(scr + 8 * r), gb = *(const LAS f32x4*)(scr + 8 * r + 4);
    const float sc = I.f8 ? 256.f : 1.f;
    const float gg[8] = {ga.x * sc, ga.y * sc, ga.z * sc, ga.w * sc, gb.x * sc, gb.y * sc, gb.z * sc, gb.w * sc};
    LAS unsigned char* orow = ot + c * (4 * 144);
    if (I.f8) {
        unsigned d[8];
#pragma unroll
        for (int i = 0; i < 8; ++i) { const f32x4 x = w[i] * gg[i]; d[i] = pg8::cvt_pk4_fp8(x.x, x.y, x.z, x.w); }
#pragma unroll
        for (int h = 0; h < 2; ++h) {
            const unsigned a0 = __builtin_amdgcn_perm(d[4 * h + 1], d[4 * h], 0x05010400u), a1 = __builtin_amdgcn_perm(d[4 * h + 1], d[4 * h], 0x07030602u);
            const unsigned b0 = __builtin_amdgcn_perm(d[4 * h + 3], d[4 * h + 2], 0x05010400u), b1 = __builtin_amdgcn_perm(d[4 * h + 3], d[4 * h + 2], 0x07030602u);
            d[4 * h]     = __builtin_amdgcn_perm(b0, a0, 0x05040100u);
            d[4 * h + 1] = __builtin_amdgcn_perm(b0, a0, 0x07060302u);
            d[4 * h + 2] = __builtin_amdgcn_perm(b1, a1, 0x05040100u);
            d[4 * h + 3] = __builtin_amdgcn_perm(b1, a1, 0x07060302u); }
        typedef unsigned u32x2v __attribute__((ext_vector_type(2)));
#pragma unroll
        for (int j = 0; j < 4; ++j) *(LAS u32x2v*)(orow + j * 144 + 32 * T + 8 * r) = (u32x2v){d[j], d[4 + j]};
    } else {
        unsigned P[8], Q[8];
#pragma unroll
        for (int i = 0; i < 8; ++i) { const f32x4 x = w[i] * gg[i]; P[i] = pg8::cvt_pk_bf16(x.x, x.y); Q[i] = pg8::cvt_pk_bf16(x.z, x.w); }
#pragma unroll
        for (int j = 0; j < 4; ++j) { v4u o;
#pragma unroll
            for (int p = 0; p < 4; ++p) { const unsigned lo = (j < 2) ? P[2 * p] : Q[2 * p], hi = (j < 2) ? P[2 * p + 1] : Q[2 * p + 1];
                o[p] = __builtin_amdgcn_perm(hi, lo, (j & 1) ? 0x07060302u : 0x05040100u); }
            *(LAS v4u*)(orow + j * 144 + 64 * (T & 1) + 16 * r) = o; }
    }
    asm volatile("" ::: "memory");
    if (T == 3 || (!I.f8 && T == 1)) {
        unsigned char* dp = I.dst + (I.f8 ? 0 : 128 * (T >> 1));
#pragma unroll
        for (int j = 0; j < 8; ++j) { const v4u v = *(const LAS v4u*)(ot + ((lane >> 3) + 8 * j) * 144 + 16 * (lane & 7)); *(v4u*)(dp + (size_t)(8 * j) * I.K) = v; }
    }
    asm volatile("" ::: "memory");
}
template <int MODE = 0>
__device__ __forceinline__ void p0_run(const P0Job& J, int w, int nw, LAS float* scr, int lane) {
    f32x4 w0[8], w1[8], w2[8], w3[8]; float k0, k1, k2, k3;
    P0Item Ic, In;
    const int T = J.total, full = T / nw, rem = T - full * nw, nblk = nw / NWAVES, share = rem / nblk, extra = rem - share * nblk, wv = w & (NWAVES - 1), blk = w / NWAVES;
#define P0_UNIT(r) ((r) < full ? (r) * nw + w : ((r) > full ? -1 : (wv < share ? full * nw + blk * share + wv : ((wv == share && blk < extra) ? full * nw + nblk * share + blk : -1))))
    int rr = 0, uc = P0_UNIT(0); if (uc < 0) return;
#define P0_NEXT(u_) do { if ((u_) >= 0) In = p0_locate(J, (u_), lane); else { In.src = g_ones; In.kg = g_ones; In.N = 0; In.kstep = 0; } } while (0)
    Ic = p0_locate(J, uc, lane); In = Ic;
    P0_LOAD(w0, k0, Ic, 0); P0_LOAD(w1, k1, Ic, 1); P0_LOAD(w2, k2, Ic, 2);
    for (;;) {
        const int un = P0_UNIT(rr + 1);
        P0_LOAD(w3, k3, Ic, 3); P0_NEXT(un); P0_WAIT(w0, k0); if (MODE != 1) p0_proc<0>(w0, k0, Ic, scr, lane);
        P0_LOAD(w0, k0, In, 0);              P0_WAIT(w1, k1); if (MODE != 1) p0_proc<1>(w1, k1, Ic, scr, lane);
        P0_LOAD(w1, k1, In, 1);              P0_WAIT(w2, k2); if (MODE != 1) p0_proc<2>(w2, k2, Ic, scr, lane);
        P0_LOAD(w2, k2, In, 2);              P0_WAIT(w3, k3); if (MODE != 1) p0_proc<3>(w3, k3, Ic, scr, lane);
        ++rr; if (un < 0) break;
        Ic = In;
    }
    asm volatile("s_waitcnt vmcnt(0)" ::: "memory");
#undef P0_NEXT
#undef P0_UNIT
}
__device__ __forceinline__ void rms_rows_to_fp8(const float* x, const float* g, unsigned char* o, bf16* xb16, int first, int step, int lane) {
    const f32x4* gr = (const f32x4*)g + lane;
    f32x4 va[8], vb[8];
#define RR_LOAD(v, m_) do { const f32x4* xr_ = (const f32x4*)(x + (size_t)(m_) * DM) + lane; _Pragma("unroll") for (int j_ = 0; j_ < 8; ++j_) v[j_] = __builtin_nontemporal_load(xr_ + 64 * j_); } while (0)
#define RR_DO(v, m_) do { float s_ = 0.f; _Pragma("unroll") for (int j_ = 0; j_ < 8; ++j_) s_ += (v[j_].x * v[j_].x + v[j_].y * v[j_].y) + (v[j_].z * v[j_].z + v[j_].w * v[j_].w); \
        const float rs_ = 1.0f / sqrtf(wave_sum(s_) * (1.f / DM) + EPS); unsigned* o4_ = (unsigned*)(o + (size_t)(m_) * DM) + lane; \
        _Pragma("unroll") for (int j_ = 0; j_ < 8; ++j_) { const f32x4 gg_ = gr[64 * j_]; o4_[64 * j_] = pg8::cvt_pk4_fp8(v[j_].x * rs_ * gg_.x, v[j_].y * rs_ * gg_.y, v[j_].z * rs_ * gg_.z, v[j_].w * rs_ * gg_.w); \
            typedef unsigned u32x2w_ __attribute__((ext_vector_type(2))); *((u32x2w_*)(xb16 + (size_t)(m_) * DM) + lane + 64 * j_) = (u32x2w_){pg8::cvt_pk_bf16(v[j_].x, v[j_].y), pg8::cvt_pk_bf16(v[j_].z, v[j_].w)}; } } while (0)
    int m = first; if (m >= M) return;
    RR_LOAD(va, m);
    for (;;) {
        const int m1 = m + step; if (m1 < M) RR_LOAD(vb, m1);
        RR_DO(va, m); if (m1 >= M) break;
        const int m2 = m1 + step; if (m2 < M) RR_LOAD(va, m2);
        RR_DO(vb, m1); if (m2 >= M) break;
        m = m2;
    }
#undef RR_LOAD
#undef RR_DO
}

constexpr int SG_STRIDE = 272;
__device__ __forceinline__ void sgu_item(Frame& F, const bf16* UG, const float* ln_g, const float* ln_b, const float* w_s, const float* b_s, bf16* MIX, float* ssg, int item) {
    const int g = item & 7, chunk = item >> 3;
    LAS unsigned char* GT = F.lds; LAS unsigned char* WL = F.lds + 128 * SG_STRIDE;
    const size_t row0 = (size_t)chunk * CHUNK;
    {
        const int s = (F.wave * 64 + mk_lane()) >> 2, cq = ((F.wave * 64 + mk_lane()) & 3) * 32;
        const bf16* gp = UG + (row0 + s) * 2048 + 1024 + g * 128 + cq;
        float x[32];
#pragma unroll
        for (int j = 0; j < 4; ++j) { const v4u w = *(const v4u*)(gp + 8 * j);
#pragma unroll
            for (int e = 0; e < 4; ++e) { x[8 * j + 2 * e] = __uint_as_float(w[e] << 16); x[8 * j + 2 * e + 1] = __uint_as_float(w[e] & 0xffff0000u); } }
        float sm = 0.f;
#pragma unroll
        for (int j = 0; j < 32; ++j) sm += x[j];
        sm += __shfl_xor(sm, 1); sm += __shfl_xor(sm, 2);
        const float mu = sm * (1.f / 128.f); float q = 0.f;
#pragma unroll
        for (int j = 0; j < 32; ++j) { x[j] -= mu; q += x[j] * x[j]; }
        q += __shfl_xor(q, 1); q += __shfl_xor(q, 2);
        const float rs = 1.0f / sqrtf(q * (1.f / 128.f) + EPS);
#pragma unroll
        for (int j = 0; j < 32; ++j) { const float y = x[j] * rs * ln_g[g * 128 + cq + j] + ln_b[g * 128 + cq + j];
            *(LAS unsigned short*)(GT + (cq + j) * SG_STRIDE + 2 * s) = (unsigned short)f2bf(y); }
    }
    {
        const int t = (F.wave * 64 + mk_lane()) >> 2, sq = ((F.wave * 64 + mk_lane()) & 3) * 32;
        const float* wp = w_s + ((size_t)g * 128 + t) * 128 + sq;
#pragma unroll
        for (int j = 0; j < 4; ++j) { const f32x4 a = *(const f32x4*)(wp + 8 * j), c = *(const f32x4*)(wp + 8 * j + 4); const int s0 = sq + 8 * j;
            v4u o; o.x = pk2(s0 + 0 <= t ? a.x : 0.f, s0 + 1 <= t ? a.y : 0.f); o.y = pk2(s0 + 2 <= t ? a.z : 0.f, s0 + 3 <= t ? a.w : 0.f);
            o.z = pk2(s0 + 4 <= t ? c.x : 0.f, s0 + 5 <= t ? c.y : 0.f); o.w = pk2(s0 + 6 <= t ? c.z : 0.f, s0 + 7 <= t ? c.w : 0.f);
            *(LAS v4u*)(WL + t * SG_STRIDE + 2 * s0) = o; }
    }
    LDS_WAIT(); __syncthreads();
    {
        const int fr = mk_lane() & 15, fq = mk_lane() >> 4, w = F.wave;
        f32x4 acc[8];
#pragma unroll
        for (int n = 0; n < 8; ++n) acc[n] = (f32x4){0.f, 0.f, 0.f, 0.f};
        const int ksn = (16 * w + 15) / 32 + 1;
        for (int ks = 0; ks < ksn; ++ks) {
            const bf16x8 bfr = *(const LAS bf16x8*)(WL + (16 * w + fr) * SG_STRIDE + 2 * (32 * ks + 8 * fq));
#pragma unroll
            for (int n = 0; n < 8; ++n) { const bf16x8 afr = *(const LAS bf16x8*)(GT + (16 * n + fr) * SG_STRIDE + 2 * (32 * ks + 8 * fq));
                acc[n] = __builtin_amdgcn_mfma_f32_16x16x32_bf16(afr, bfr, acc[n], 0, 0, 0); }
        }
        const int t = 16 * w + fr; const float bias = b_s[g * 128 + t];
        const bf16* up = UG + (row0 + t) * 2048 + g * 128 + 4 * fq; unsigned char* op = (unsigned char*)MIX + (row0 + t) * 2048 + 1024 + g * 128 + 4 * fq; float qs = 0.f;
#pragma unroll
        for (int n = 0; n < 8; ++n) { const unsigned long long uw = *(const unsigned long long*)(up + 16 * n); const unsigned u0 = (unsigned)uw, u1 = (unsigned)(uw >> 32);
            const float o0 = __uint_as_float(u0 << 16) * (acc[n][0] + bias), o1 = __uint_as_float(u0 & 0xffff0000u) * (acc[n][1] + bias);
            const float o2 = __uint_as_float(u1 << 16) * (acc[n][2] + bias), o3 = __uint_as_float(u1 & 0xffff0000u) * (acc[n][3] + bias);
            const unsigned w0 = pg8::cvt_pk4_fp8(o0, o1, o2, o3);
            *(unsigned*)(op + 16 * n) = w0;
            const float y0 = __builtin_amdgcn_cvt_f32_fp8((int)w0, 0), y1 = __builtin_amdgcn_cvt_f32_fp8((int)w0, 1), y2 = __builtin_amdgcn_cvt_f32_fp8((int)w0, 2), y3 = __builtin_amdgcn_cvt_f32_fp8((int)w0, 3);
            qs += (y0 * y0 + y1 * y1) + (y2 * y2 + y3 * y3); }
        qs += __shfl_xor(qs, 16); qs += __shfl_xor(qs, 32);
        if (fq == 0) ssg[(row0 + t) * 8 + g] = qs;
    }
    __syncthreads();
}

__device__ __forceinline__ void sgu_pair(Frame& F, const bf16* UG, const float* ln_g, const float* ln_b, const float* w_s, const float* b_s, bf16* MIX, float* ssg, int item0, int item1) {
    const int g = item0 & 7;
    LAS unsigned char* GT = F.lds; LAS unsigned char* WL = F.lds + 256 * SG_STRIDE;
    const size_t row0[2] = {(size_t)(item0 >> 3) * CHUNK, (size_t)(item1 >> 3) * CHUNK};
    {
        const int s = (F.wave * 64 + mk_lane()) >> 2, cq = ((F.wave * 64 + mk_lane()) & 3) * 32;
        v4u raw[2][4];
#pragma unroll
        for (int q = 0; q < 2; ++q) { const bf16* gp = UG + (row0[q] + s) * 2048 + 1024 + g * 128 + cq;
#pragma unroll
            for (int j = 0; j < 4; ++j) raw[q][j] = *(const v4u*)(gp + 8 * j); }
#pragma unroll
        for (int q = 0; q < 2; ++q) {
            float x[32];
#pragma unroll
            for (int j = 0; j < 4; ++j) { const v4u w = raw[q][j];
#pragma unroll
                for (int e = 0; e < 4; ++e) { x[8 * j + 2 * e] = __uint_as_float(w[e] << 16); x[8 * j + 2 * e + 1] = __uint_as_float(w[e] & 0xffff0000u); } }
            float sm = 0.f;
#pragma unroll
            for (int j = 0; j < 32; ++j) sm += x[j];
            sm += __shfl_xor(sm, 1); sm += __shfl_xor(sm, 2);
            const float mu = sm * (1.f / 128.f); float qq = 0.f;
#pragma unroll
            for (int j = 0; j < 32; ++j) { x[j] -= mu; qq += x[j] * x[j]; }
            qq += __shfl_xor(qq, 1); qq += __shfl_xor(qq, 2);
            const float rs = 1.0f / sqrtf(qq * (1.f / 128.f) + EPS);
#pragma unroll
            for (int j = 0; j < 32; ++j) { const float y = x[j] * rs * ln_g[g * 128 + cq + j] + ln_b[g * 128 + cq + j];
                *(LAS unsigned short*)(GT + q * 128 * SG_STRIDE + (cq + j) * SG_STRIDE + 2 * s) = (unsigned short)f2bf(y); }
        }
    }
    {
        const int t = (F.wave * 64 + mk_lane()) >> 2, sq = ((F.wave * 64 + mk_lane()) & 3) * 32;
        const float* wp = w_s + ((size_t)g * 128 + t) * 128 + sq;
#pragma unroll
        for (int j = 0; j < 4; ++j) { const f32x4 a = *(const f32x4*)(wp + 8 * j), c = *(const f32x4*)(wp + 8 * j + 4); const int s0 = sq + 8 * j;
            v4u o; o.x = pk2(s0 + 0 <= t ? a.x : 0.f, s0 + 1 <= t ? a.y : 0.f); o.y = pk2(s0 + 2 <= t ? a.z : 0.f, s0 + 3 <= t ? a.w : 0.f);
            o.z = pk2(s0 + 4 <= t ? c.x : 0.f, s0 + 5 <= t ? c.y : 0.f); o.w = pk2(s0 + 6 <= t ? c.z : 0.f, s0 + 7 <= t ? c.w : 0.f);
            *(LAS v4u*)(WL + t * SG_STRIDE + 2 * s0) = o; }
    }
    LDS_WAIT(); __syncthreads();
    {
        const int fr = mk_lane() & 15, fq = mk_lane() >> 4, w = F.wave;
        f32x4 acc[2][8];
#pragma unroll
        for (int q = 0; q < 2; ++q)
#pragma unroll
            for (int n = 0; n < 8; ++n) acc[q][n] = (f32x4){0.f, 0.f, 0.f, 0.f};
        const int ksn = (16 * w + 15) / 32 + 1;
        for (int ks = 0; ks < ksn; ++ks) {
            const bf16x8 bfr = *(const LAS bf16x8*)(WL + (16 * w + fr) * SG_STRIDE + 2 * (32 * ks + 8 * fq));
#pragma unroll
            for (int q = 0; q < 2; ++q)
#pragma unroll
                for (int n = 0; n < 8; ++n) { const bf16x8 afr = *(const LAS bf16x8*)(GT + q * 128 * SG_STRIDE + (16 * n + fr) * SG_STRIDE + 2 * (32 * ks + 8 * fq));
                    acc[q][n] = __builtin_amdgcn_mfma_f32_16x16x32_bf16(afr, bfr, acc[q][n], 0, 0, 0); }
        }
        const int t = 16 * w + fr; const float bias = b_s[g * 128 + t];
#pragma unroll
        for (int q = 0; q < 2; ++q) {
            const bf16* up = UG + (row0[q] + t) * 2048 + g * 128 + 4 * fq; unsigned char* op = (unsigned char*)MIX + (row0[q] + t) * 2048 + 1024 + g * 128 + 4 * fq; float qs = 0.f;
#pragma unroll
            for (int n = 0; n < 8; ++n) { const unsigned long long uw = *(const unsigned long long*)(up + 16 * n); const unsigned u0 = (unsigned)uw, u1 = (unsigned)(uw >> 32);
                const float o0 = __uint_as_float(u0 << 16) * (acc[q][n][0] + bias), o1 = __uint_as_float(u0 & 0xffff0000u) * (acc[q][n][1] + bias);
                const float o2 = __uint_as_float(u1 << 16) * (acc[q][n][2] + bias), o3 = __uint_as_float(u1 & 0xffff0000u) * (acc[q][n][3] + bias);
                const unsigned w0 = pg8::cvt_pk4_fp8(o0, o1, o2, o3);
                *(unsigned*)(op + 16 * n) = w0;
                const float y0 = __builtin_amdgcn_cvt_f32_fp8((int)w0, 0), y1 = __builtin_amdgcn_cvt_f32_fp8((int)w0, 1), y2 = __builtin_amdgcn_cvt_f32_fp8((int)w0, 2), y3 = __builtin_amdgcn_cvt_f32_fp8((int)w0, 3);
                qs += (y0 * y0 + y1 * y1) + (y2 * y2 + y3 * y3); }
            qs += __shfl_xor(qs, 16); qs += __shfl_xor(qs, 32);
            if (fq == 0) ssg[(row0[q] + t) * 8 + g] = qs;
        }
    }
    __syncthreads();
}
__device__ __forceinline__ void norm2_row(bf16* row, int lane) {
    v4u* p = (v4u*)row + lane;
#pragma unroll
    for (int hsel = 0; hsel < 2; ++hsel) {
        v4u w[2]; float x[16]; float s = 0.f;
#pragma unroll
        for (int j = 0; j < 2; ++j) { w[j] = p[hsel * 128 + 64 * j];
#pragma unroll
            for (int e = 0; e < 4; ++e) { x[8 * j + 2 * e] = __uint_as_float(w[j][e] << 16); x[8 * j + 2 * e + 1] = __uint_as_float(w[j][e] & 0xffff0000u); } }
#pragma unroll
        for (int j = 0; j < 16; ++j) s += x[j] * x[j];
        const float rs = 1.0f / sqrtf(wave_sum(s) * (1.f / 1024.f) + EPS);
#pragma unroll
        for (int j = 0; j < 2; ++j) { v4u o;
#pragma unroll
            for (int e = 0; e < 4; ++e) o[e] = pk2(x[8 * j + 2 * e] * rs, x[8 * j + 2 * e + 1] * rs);
            p[hsel * 128 + 64 * j] = o; }
    }
}
constexpr int BAR_DONE = XCD_BAR_WORDS;
__device__ unsigned g_bar[XCD_BAR_WORDS + 64];
struct Args { const float* in[20]; float* out; unsigned char* ws; int ph_lo, ph_hi; };
__global__ void __launch_bounds__(NWAVES * 64, 2) hymba_fwd(Args args) {
    extern __shared__ __attribute__((aligned(16))) unsigned char lds[];
    Frame F;
    F.lds = (LAS unsigned char*)lds;
    F.MISC = (volatile LAS unsigned*)(F.lds + MISC_OFF);
    F.wave = __builtin_amdgcn_readfirstlane((int)threadIdx.x >> 6);
    F.G = gridDim.x; { const int bx = blockIdx.x; F.vcu = (F.G % 8 == 0) ? (bx % 8) * (F.G / 8) + bx / 8 : bx; }
    unsigned char* ws = args.ws;
    F.ctl = (gu32*)(ws + WS_CTL);
    const float* x = args.in[0];
    float* out = args.out;
    bf16* W1t = (bf16*)(ws + WS_W1); bf16* W2t = (bf16*)(ws + WS_W2); bf16* Wint = (bf16*)(ws + WS_WIN); bf16* Wvug = (bf16*)(ws + WS_WIN + 8 * MiB);   bf16* Woutt = (bf16*)(ws + WS_WOUT); bf16* W5t = (bf16*)(ws + WS_W5); bf16* W6t = (bf16*)(ws + WS_W6);
    bf16* XA = (bf16*)(ws + WS_XA); bf16* XB = (bf16*)(ws + WS_XB); bf16* ACT = (bf16*)(ws + WS_ACT);
    bf16* X2B = (bf16*)(ws + WS_X2B); unsigned char* X1F8 = ws + WS_X1F8;
    bf16* QK = (bf16*)(ws + WS_QK); bf16* VB = (bf16*)(ws + WS_V); bf16* UG = (bf16*)(ws + WS_UG); bf16* MIX = (bf16*)(ws + WS_MIX);
    float* SS1 = (float*)(ws + WS_SS1); float* SS2 = (float*)(ws + WS_SS2); float* KMEAN = (float*)(ws + WS_KMEAN); float* SSA = (float*)(ws + WS_SSA); float* SSG = (float*)(ws + WS_SSG);
    for (int u = (F.wave * 64 + mk_lane()); u < (LDS_BYTES - LDSCTL_OFF) / 4; u += NWAVES * 64) ((LAS unsigned*)(F.lds + LDSCTL_OFF))[u] = 0u;
    __syncthreads();
    XcdBarrier bar; bar.bar = g_bar; bar.x = 0; bar.st = nullptr;
    if (N_LAUNCHES == 1) bar = xcd_barrier_post(g_bar, F.MISC + 8, F.wave == 0 && mk_lane() == 0);
    const int lo = args.ph_lo, hi = args.ph_hi;
#define IN(k) (lo <= (k) && (k) < hi)
#define SEAM(k) do { if (IN(k) && IN((k) + 1)) xcd_barrier(bar, F.wave == 0 && mk_lane() == 0); } while (0)
    const int gw = F.vcu * NWAVES + F.wave, NGW = F.G * NWAVES;

    LAS float* scr = (LAS float*)(F.lds + F.wave * 16384);
    if (IN(0)) {
        rms_rows_to_fp8(x, args.in[1], (unsigned char*)XA, (bf16*)(ws + WS_UG), gw, NGW, mk_lane());
        P0Job J; J.m0 = P0Mat{args.in[2], DM, DFF, W1t, nullptr, 1, DM, 1, DFF}; J.m1 = P0Mat{args.in[3], DM, DFF, W1t, nullptr, 2, DM, 1, DFF}; J.m2 = J.m0; J.m3 = J.m0;
        J.c0 = p0_cnt(J.m0); J.c1 = p0_cnt(J.m1); J.c2 = 0; J.c3 = 0; J.total = J.c0 + J.c1;
        p0_run(J, gw, NGW, scr, mk_lane());
    }
    SEAM(0);
    if (IN(1)) {
        pg8::Gemm g{XA, W1t, M, N1, DM / 2}; pg8::EpiSwiGLU<true> E{ACT, DFF, nullptr, 1.0f / 256.0f};
#pragma nounroll
        for (int seg = 0; seg < 2; ++seg) {
            { int bx = (int)blockIdx.x; asm volatile("" : "+s"(bx));
              const int nrem = ((M / 256) * (N1 / 256)) % F.G; const int cut = (!nrem || bx >= nrem) ? 1 + (bx - nrem) % 5 : (1 << 20);
              pg8::StaticOrder S; S.init(M, N1, F.G, bx, WGM_FF1); S.i0 = seg ? cut : 0; S.i1 = seg ? (1 << 20) : cut;
              int wv = F.wave; asm volatile("" : "+s"(wv));
              pg8::gemm_phase<pg8::EpiSwiGLU<true>, pg8::StaticOrder, true, true, true>(F.lds, g, S, E, wv); }
            int bx = (int)blockIdx.x; asm volatile("" : "+s"(bx));
            const int nrem = ((M / 256) * (N1 / 256)) % F.G, nidle = nrem ? F.G - nrem : F.G;
            if (seg == 0 && (!nrem || bx >= nrem)) {
                P0Job J; J.m0 = P0Mat{args.in[4], DFF, DM, W2t, nullptr, 0, DFF, 1, DM}; J.m1 = P0Mat{args.in[6], DM, 2048, Wint, args.in[5], 0, DM, 0, DIN};
                J.m2 = P0Mat{args.in[6] + 2048, DM, 3072, Wvug, args.in[5], 0, DM, 1, DIN}; J.m3 = P0Mat{args.in[15], DATT, DM, Woutt, args.in[13], 0, DM, 1, DM};
                J.c0 = p0_cnt(J.m0); J.c1 = p0_cnt(J.m1); J.c2 = p0_cnt(J.m2); J.c3 = p0_cnt(J.m3); J.total = J.c0 + J.c1 + J.c2 + J.c3;
                p0_run(J, (nrem ? bx - nrem : bx) * NWAVES + F.wave, nidle * NWAVES, scr, mk_lane());
                LDS_WAIT(); __syncthreads();
            }
        }
    }
    SEAM(1);
    if (IN(2)) {
        pg8::Gemm g{ACT, W2t, M, DM, DFF / 2}; pg8::StaticOrder S; S.init(M, DM, F.G, (int)blockIdx.x, WGM_RES);
        pg8::EpiResid<true> E{(const bf16*)(ws + WS_UG), nullptr, XB, X1F8, SS1, 0.5f / 256.0f, nullptr};
        pg8::gemm_phase<pg8::EpiResid<true>, pg8::StaticOrder, false, true, true>(F.lds, g, S, E, F.wave);
    }
    SEAM(2);
    if (IN(3)) {
        { pg8::Gemm g{XB, Wint, M, 2048, DM}; pg8::StaticOrder S; S.init(M, 2048, F.G, (int)blockIdx.x, WGM_RES);
          pg8::EpiG3 E{QK, VB, UG, SS1, args.in[7], args.in[8], KMEAN, F.lds + G3X_OFF, QSCALE, 0, 1.0f};
          pg8::gemm_phase<pg8::EpiG3, pg8::StaticOrder, true, true>(F.lds, g, S, E, F.wave); }
        { pg8::Gemm g{(const bf16*)X1F8, Wvug, M, 3072, DM / 2}; pg8::StaticOrder S; S.init(M, 3072, F.G, (int)blockIdx.x, WGM_IN);
          pg8::EpiVUG E{VB, UG, SS1, 1.0f / 256.0f};
          pg8::gemm_phase<pg8::EpiVUG, pg8::StaticOrder, true, true, true>(F.lds, g, S, E, F.wave); }
        const int nrem = ((M / 256) * (3072 / 256)) % F.G, nidle = nrem ? F.G - nrem : F.G;
        if (!nrem || (int)blockIdx.x >= nrem) {
            P0Job J; J.m0 = P0Mat{args.in[17], DM, DFF, W5t, args.in[16], 1, DM, 1, DFF}; J.m1 = P0Mat{args.in[18], DM, DFF, W5t, args.in[16], 2, DM, 1, DFF};
            J.m2 = P0Mat{args.in[15] + (size_t)DATT * DM, DSGU, DM, (bf16*)((unsigned char*)Woutt + DATT), args.in[14], 0, DM, 1, DM}; J.m3 = J.m0;
            J.c0 = p0_cnt(J.m0); J.c1 = p0_cnt(J.m1); J.c2 = p0_cnt(J.m2); J.c3 = 0; J.total = J.c0 + J.c1 + J.c2;
            p0_run(J, (nrem ? (int)blockIdx.x - nrem : (int)blockIdx.x) * NWAVES + F.wave, nidle * NWAVES, scr, mk_lane());
        }
    }
    SEAM(3);
    if (IN(5)) {
        for (int pr = F.vcu; pr < 256; pr += F.G) {
            const int bh0 = (pr >> 5) * 2, c = pr & 31, j = c >> 1, qbA = j >> 1, half = j & 1, role = c & 1;
            att::attn_unit(bh0 >> 3, bh0 & 7, role ? qbA : 15 - qbA, half, (const unsigned char*)QK, VB, KMEAN, MIX, SSA, F.lds, F.wave);
            att::attn_unit((bh0 + 1) >> 3, (bh0 + 1) & 7, role ? 15 - qbA : qbA, 1 - half, (const unsigned char*)QK, VB, KMEAN, MIX, SSA, F.lds, F.wave); }
        if (F.G == 256) sgu_pair(F, UG, args.in[9], args.in[10], args.in[11], args.in[12], MIX, SSG, F.vcu, F.vcu + 256);
        else for (int it = F.vcu; it < 512; it += F.G) sgu_item(F, UG, args.in[9], args.in[10], args.in[11], args.in[12], MIX, SSG, it);
    }
    SEAM(5);
    if (IN(7)) {
        pg8::Gemm g{MIX, Woutt, M, DM, DM / 2}; pg8::StaticOrder S; S.init(M, DM, F.G, (int)blockIdx.x, WGM_RES);
        { pg8::Unit u0; if (S.next(0, u0)) { const int t = F.wave * 64 + mk_lane();
              if (t < 256) { const size_t row = (size_t)u0.pm * 256 + t; const f32x4 a0 = *(const f32x4*)(SSA + row * 8), a1 = *(const f32x4*)(SSA + row * 8 + 4), g0 = *(const f32x4*)(SSG + row * 8), g1 = *(const f32x4*)(SSG + row * 8 + 4);
                  const float sa = ((a0[0] + a0[1]) + (a0[2] + a0[3])) + ((a1[0] + a1[1]) + (a1[2] + a1[3])), sg = ((g0[0] + g0[1]) + (g0[2] + g0[3])) + ((g1[0] + g1[1]) + (g1[2] + g1[3]));
                  const float ra = 1.0f / sqrtf(sa * (1.0f / 1024.0f) + 256.0f * EPS), rs = 1.0f / sqrtf(sg * (1.0f / 1024.0f) + EPS);
                  LAS float* T = (LAS float*)(F.lds + G3X_OFF); T[2 * t] = ra / rs; T[2 * t + 1] = rs; } }
          LDS_WAIT(); __syncthreads(); }
        pg8::EpiResid<true, true> E{XB, nullptr, X2B, (unsigned char*)XA, SS2, 1.0f / 256.0f, (const LAS float*)(F.lds + G3X_OFF)};
        pg8::gemm_phase<pg8::EpiResid<true, true>, pg8::StaticOrder, false, true, true>(F.lds, g, S, E, F.wave);
    }
    SEAM(7);
    if (IN(8)) {
        pg8::Gemm g{XA, W5t, M, N1, DM / 2}; pg8::StaticOrder S; S.init(M, N1, F.G, (int)blockIdx.x, WGM_FF1);
        pg8::EpiSwiGLU<true> E{ACT, DFF, SS2, 1.0f / 256.0f};
        pg8::gemm_phase<pg8::EpiSwiGLU<true>, pg8::StaticOrder, true, true, true>(F.lds, g, S, E, F.wave);
        const int nrem = ((M / 256) * (N1 / 256)) % F.G, nidle = nrem ? F.G - nrem : F.G;
        if (!nrem || (int)blockIdx.x >= nrem) {
            P0Job J; J.m0 = P0Mat{args.in[19], DFF, DM, W6t, nullptr, 0, DFF, 1, DM}; J.m1 = J.m0; J.m2 = J.m0; J.m3 = J.m0;
            J.c0 = p0_cnt(J.m0); J.c1 = 0; J.c2 = 0; J.c3 = 0; J.total = J.c0;
            p0_run(J, (nrem ? (int)blockIdx.x - nrem : (int)blockIdx.x) * NWAVES + F.wave, nidle * NWAVES, scr, mk_lane());
        }
    }
    SEAM(8);
    if (IN(9)) {
        pg8::Gemm g{ACT, W6t, M, DM, DFF / 2}; pg8::StaticOrder S; S.init(M, DM, F.G, (int)blockIdx.x, WGM_RES);
        pg8::EpiResid<true> E{X2B, out, nullptr, nullptr, nullptr, 0.5f / 256.0f, nullptr};
        pg8::gemm_phase<pg8::EpiResid<true>, pg8::StaticOrder, false, true, true>(F.lds, g, S, E, F.wave);
    }
    if (F.wave == 0 && mk_lane() == 0) F.MISC[12] = (xb_add(&g_bar[BAR_DONE], 1u) == (unsigned)gridDim.x - 1u) ? 1u : 0u;
    __syncthreads();
    if (F.MISC[12]) { for (int i = F.wave * 64 + mk_lane(); i < XCD_BAR_WORDS + 64; i += NWAVES * 64) __hip_atomic_store(&g_bar[i], 0u, __ATOMIC_RELAXED, __HIP_MEMORY_SCOPE_AGENT); }
#undef IN
#undef SEAM
}

extern "C" void kernel_launch(void* const* d_in, const int* in_sizes, int n_in, void* d_out, int out_size, void* d_ws, size_t ws_size, hipStream_t stream) {
    static int grid = 0;
    if (grid == 0) {
        if (n_in != 20 || in_sizes[0] != M * DM || out_size != M * DM || ws_size < WS_END) { fprintf(stderr, "kernel_launch: shape/workspace mismatch (n_in %d, in0 %d, out %d, ws %zu, need %zu); nothing launched\n", n_in, n_in > 0 ? in_sizes[0] : -1, out_size, ws_size, (size_t)WS_END); grid = -1; return; }
        int dev = 0, cus = 0, per_cu = 0;
        if (hipGetDevice(&dev) != hipSuccess || hipDeviceGetAttribute(&cus, hipDeviceAttributeMultiprocessorCount, dev) != hipSuccess) { grid = -1; return; }
        if (hipFuncSetAttribute((const void*)hymba_fwd, hipFuncAttributeMaxDynamicSharedMemorySize, LDS_BYTES) != hipSuccess) { fprintf(stderr, "kernel_launch: hipFuncSetAttribute failed\n"); grid = -1; return; }
        if (hipOccupancyMaxActiveBlocksPerMultiprocessor(&per_cu, (const void*)hymba_fwd, NWAVES * 64, LDS_BYTES) != hipSuccess || per_cu < 1) { fprintf(stderr, "kernel_launch: occupancy query says %d blocks per CU\n", per_cu); }
        (void)hipGetLastError();
        grid = cus;
        if (grid != 256) fprintf(stderr, "kernel_launch: %d CUs; the residual GEMM phases assume 256 workgroups\n", grid);
    }
    if (grid < 0) return;
    Args a{};
    for (int i = 0; i < 20; ++i) a.in[i] = (const float*)d_in[i];
    a.out = (float*)d_out; a.ws = (unsigned char*)d_ws;
    for (int li = 0; li < N_LAUNCHES; ++li) {
        a.ph_lo = (N_LAUNCHES == 1) ? 0 : li; a.ph_hi = (N_LAUNCHES == 1) ? N_PHASES : li + 1;
        hipLaunchKernelGGL(hymba_fwd, dim3(grid), dim3(NWAVES * 64), LDS_BYTES, stream, a);
    }
}
```
